# Optimizing an MI355X kernel written in HIP

```python
import math
import jax, jax.numpy as jnp
from jax import lax
import numpy as np

D_MODEL = 1024
BATCH = 8
SEQ = 2048
DEPTH = 1
DEC_BATCH = 128
DEC_SEQ = 4
PAST_LEN = 16384
PAGE_SIZE = 128

MIX_WIDTH = D_MODEL
RET_WIDTH = MIX_WIDTH // 2
CONV_WIDTH = MIX_WIDTH - RET_WIDTH
RET_HEADS = 4
RET_DK = RET_WIDTH // RET_HEADS
RET_DV = RET_WIDTH // RET_HEADS
RET_QK = RET_HEADS * RET_DK
RET_CHUNK = 128
ROPE_BASE = 10000.0
CONV_K = 31
CONV_BUF = CONV_K - 1
D_FF = ((8 * D_MODEL // 3 + 127) // 128) * 128
N_MOD = 9
EPS = 1e-6
IN_COLS = 2 * RET_QK + 2 * RET_WIDTH + 2 * CONV_WIDTH
SPLITS = [RET_QK, 2 * RET_QK, 2 * RET_QK + RET_WIDTH, 2 * RET_QK + 2 * RET_WIDTH,
          2 * RET_QK + 2 * RET_WIDTH + CONV_WIDTH]

kernel_name = 'hybrid_retention_conformer_conv_macaron_adaln_step'


def rmsnorm(x, g):
    xf = x.astype(jnp.float32)
    y = xf * lax.rsqrt(jnp.mean(xf * xf, axis=-1, keepdims=True) + EPS)
    return (y * g.astype(jnp.float32)).astype(x.dtype)


def swiglu(h, w_gate, w_up, w_down):
    return (jax.nn.silu(h @ w_gate) * (h @ w_up)) @ w_down


def rotary(x, pos):
    half = x.shape[-1] // 2
    inv = ROPE_BASE ** (-jnp.arange(half, dtype=jnp.float32) / half)
    ang = pos[:, None] * inv[None, :]
    cos = jnp.cos(ang)[None, :, None, :]
    sin = jnp.sin(ang)[None, :, None, :]
    x1, x2 = x[..., :half], x[..., half:]
    return jnp.concatenate([x1 * cos - x2 * sin, x1 * sin + x2 * cos], axis=-1)


def log_gammas():
    return jnp.log(1.0 - 2.0 ** (-5.0 - jnp.arange(RET_HEADS, dtype=jnp.float32)))


def retention_chunk(S, qkv):
    q, k, v = qkv
    C = q.shape[1]
    lg = log_gammas()
    idx = jnp.arange(C, dtype=jnp.float32)
    diff = idx[:, None] - idx[None, :]
    dmask = jnp.where(diff[None] >= 0, jnp.exp(lg[:, None, None] * jnp.maximum(diff, 0.0)[None]), 0.0)
    scores = jnp.einsum('bihd,bjhd->bhij', q, k) * dmask[None]
    inner = jnp.einsum('bhij,bjhe->bihe', scores, v)
    decay_q = jnp.exp(lg[None, :] * (idx[:, None] + 1.0))
    cross = jnp.einsum('bihd,bhde->bihe', q, S) * decay_q[None, :, :, None]
    decay_k = jnp.exp(lg[None, :] * (C - 1.0 - idx[:, None]))
    S_new = jnp.exp(lg * C)[None, :, None, None] * S + jnp.einsum(
        'bjhd,bjhe->bhde', k * decay_k[None, :, :, None], v)
    return S_new, inner + cross


def retention(q, k, v, S0):
    B, T, H, _ = q.shape
    C = RET_CHUNK if T % RET_CHUNK == 0 else T
    n = T // C
    to_chunks = lambda a: a.reshape(B, n, C, H, a.shape[-1]).transpose(1, 0, 2, 3, 4)
    S, out = lax.scan(retention_chunk, S0, (to_chunks(q), to_chunks(k), to_chunks(v)))
    return S, out.transpose(1, 0, 2, 3, 4).reshape(B, T, H, RET_DV)


def conv_module(a, b, buf, dw_w, dw_b, ln_g, ln_b):
    u = a * jax.nn.sigmoid(b)
    up = jnp.concatenate([buf.astype(u.dtype), u], axis=1)
    y = lax.conv_general_dilated(up, dw_w[:, None, :].astype(u.dtype), window_strides=(1,),
                                 padding='VALID', dimension_numbers=('NWC', 'WIO', 'NWC'),
                                 feature_group_count=CONV_WIDTH) + dw_b
    yf = y.astype(jnp.float32)
    mu = jnp.mean(yf, axis=-1, keepdims=True)
    var = jnp.mean(jnp.square(yf - mu), axis=-1, keepdims=True)
    yn = (yf - mu) * lax.rsqrt(var + EPS) * ln_g.astype(jnp.float32) + ln_b.astype(jnp.float32)
    return jax.nn.silu(yn).astype(a.dtype), up[:, -CONV_BUF:]


def decoder_layer(x, c, pos0, S0, buf0, norm_ffn1, ffn1_w_gate, ffn1_w_up, ffn1_w_down,
                  norm_mix, w_in, ret_gn_gain, dw_w, dw_b, conv_ln_gain, conv_ln_bias, w_out,
                  norm_ffn2, ffn2_w_gate, ffn2_w_up, ffn2_w_down, w_ada, b_ada):
    B, T, _ = x.shape
    ada = (jax.nn.silu(c) @ w_ada + b_ada).reshape(B, N_MOD, D_MODEL)[:, :, None, :]
    sh1, sc1, g1, sh2, sc2, g2, sh3, sc3, g3 = [ada[:, i] for i in range(N_MOD)]
    h = rmsnorm(x, norm_ffn1) * (1.0 + sc1) + sh1
    x = x + 0.5 * g1 * swiglu(h, ffn1_w_gate, ffn1_w_up, ffn1_w_down)
    h = rmsnorm(x, norm_mix) * (1.0 + sc2) + sh2
    q, k, v, g, a, b = jnp.split(h @ w_in, SPLITS, axis=-1)
    pos = (pos0 + jnp.arange(T, dtype=jnp.int32)).astype(jnp.float32)
    qh = rotary(q.reshape(B, T, RET_HEADS, RET_DK).astype(jnp.float32), pos)
    kh = rotary(k.reshape(B, T, RET_HEADS, RET_DK).astype(jnp.float32), pos) * (RET_DK ** -0.5)
    vh = v.reshape(B, T, RET_HEADS, RET_DV).astype(jnp.float32)
    S_new, o = retention(qh, kh, vh, S0.astype(jnp.float32))
    mu = jnp.mean(o, axis=-1, keepdims=True)
    var = jnp.mean(jnp.square(o - mu), axis=-1, keepdims=True)
    o = ((o - mu) * lax.rsqrt(var + EPS)).reshape(B, T, RET_WIDTH) * ret_gn_gain.astype(jnp.float32)
    ret_out = (jax.nn.silu(g.astype(jnp.float32)) * o).astype(x.dtype)
    conv_out, buf_new = conv_module(a, b, buf0, dw_w, dw_b, conv_ln_gain, conv_ln_bias)
    x = x + g2 * (jnp.concatenate([ret_out, conv_out], axis=-1) @ w_out)
    h = rmsnorm(x, norm_ffn2) * (1.0 + sc3) + sh3
    x = x + 0.5 * g3 * swiglu(h, ffn2_w_gate, ffn2_w_up, ffn2_w_down)
    return x, S_new, buf_new


def setup_inputs(seed: int = 0) -> dict:
    key = jax.random.key(seed)
    ks = jax.random.split(key, 26)
    f32 = jnp.float32
    nrm = lambda k, shape, s: jax.random.normal(k, shape, f32) * s
    gain = lambda k, shape: 1.0 + 0.02 * jax.random.normal(k, shape, f32)
    L = DEPTH
    return {
        'x_prompt': nrm(ks[0], (BATCH, SEQ, D_MODEL), 1.0),
        'x_sample': nrm(ks[1], (DEC_BATCH, DEC_SEQ, D_MODEL), 1.0),
        'c_prompt': nrm(ks[2], (BATCH, D_MODEL), 1.0),
        'c_sample': nrm(ks[3], (DEC_BATCH, D_MODEL), 1.0),
        'state_ret': nrm(ks[4], (L, DEC_BATCH, RET_HEADS, RET_DK, RET_DV), 0.5),
        'state_conv': nrm(ks[5], (L, DEC_BATCH, CONV_BUF, CONV_WIDTH), 0.5),
        'norm_ffn1': gain(ks[6], (L, D_MODEL)),
        'ffn1_w_gate': nrm(ks[7], (L, D_MODEL, D_FF), D_MODEL ** -0.5),
        'ffn1_w_up': nrm(ks[8], (L, D_MODEL, D_FF), D_MODEL ** -0.5),
        'ffn1_w_down': nrm(ks[9], (L, D_FF, D_MODEL), D_FF ** -0.5),
        'norm_mix': gain(ks[10], (L, D_MODEL)),
        'w_in': nrm(ks[11], (L, D_MODEL, IN_COLS), D_MODEL ** -0.5),
        'ret_gn_gain': gain(ks[12], (L, RET_WIDTH)),
        'dw_w': nrm(ks[13], (L, CONV_K, CONV_WIDTH), CONV_K ** -0.5),
        'dw_b': nrm(ks[14], (L, CONV_WIDTH), 0.02),
        'conv_ln_gain': gain(ks[15], (L, CONV_WIDTH)),
        'conv_ln_bias': nrm(ks[16], (L, CONV_WIDTH), 0.02),
        'w_out': nrm(ks[17], (L, MIX_WIDTH, D_MODEL), MIX_WIDTH ** -0.5),
        'norm_ffn2': gain(ks[18], (L, D_MODEL)),
        'ffn2_w_gate': nrm(ks[19], (L, D_MODEL, D_FF), D_MODEL ** -0.5),
        'ffn2_w_up': nrm(ks[20], (L, D_MODEL, D_FF), D_MODEL ** -0.5),
        'ffn2_w_down': nrm(ks[21], (L, D_FF, D_MODEL), D_FF ** -0.5),
        'w_ada': nrm(ks[22], (L, D_MODEL, N_MOD * D_MODEL), 0.5 * D_MODEL ** -0.5),
        'b_ada': nrm(ks[23], (L, N_MOD * D_MODEL), 0.01),
        'norm_final': gain(ks[24], (D_MODEL,)),
    }


def reference(x_prompt, x_sample, c_prompt, c_sample, state_ret, state_conv,
              norm_ffn1, ffn1_w_gate, ffn1_w_up, ffn1_w_down, norm_mix, w_in, ret_gn_gain,
              dw_w, dw_b, conv_ln_gain, conv_ln_bias, w_out, norm_ffn2, ffn2_w_gate,
              ffn2_w_up, ffn2_w_down, w_ada, b_ada, norm_final):
    yp, ys = x_prompt, x_sample
    Bp = x_prompt.shape[0]
    ret_p, conv_p, ret_s, conv_s = [], [], [], []
    for l in range(DEPTH):
        lw = (norm_ffn1[l], ffn1_w_gate[l], ffn1_w_up[l], ffn1_w_down[l], norm_mix[l], w_in[l],
              ret_gn_gain[l], dw_w[l], dw_b[l], conv_ln_gain[l], conv_ln_bias[l], w_out[l],
              norm_ffn2[l], ffn2_w_gate[l], ffn2_w_up[l], ffn2_w_down[l], w_ada[l], b_ada[l])
        S0p = jnp.zeros((Bp, RET_HEADS, RET_DK, RET_DV), jnp.float32)
        buf0p = jnp.zeros((Bp, CONV_BUF, CONV_WIDTH), x_prompt.dtype)
        yp, Sp, bp = decoder_layer(yp, c_prompt, 0, S0p, buf0p, *lw)
        ys, Ss, bs = decoder_layer(ys, c_sample, PAST_LEN, state_ret[l], state_conv[l], *lw)
        ret_p.append(Sp)
        conv_p.append(bp)
        ret_s.append(Ss)
        conv_s.append(bs)
    y_prompt = rmsnorm(yp, norm_final)
    y_sample = rmsnorm(ys, norm_final)
    ret_state_prompt = jnp.stack(ret_p).astype(state_ret.dtype)
    conv_state_prompt = jnp.stack(conv_p).astype(state_conv.dtype)
    ret_state_sample = jnp.stack(ret_s).astype(state_ret.dtype)
    conv_state_sample = jnp.stack(conv_s).astype(state_conv.dtype)
    return (y_prompt, y_sample, ret_state_prompt, conv_state_prompt, ret_state_sample, conv_state_sample)
```

```cpp
#include <hip/hip_runtime.h>
#include <hip/hip_cooperative_groups.h>
#include <cstdio>
#include <cstdint>
namespace cg = cooperative_groups;
namespace pg8 {
#define PG8_LAS __attribute__((address_space(3)))
typedef unsigned short bf16_t;
typedef short bf16x8 __attribute__((ext_vector_type(8)));
typedef float f32x4 __attribute__((ext_vector_type(4)));
typedef unsigned u32x4 __attribute__((ext_vector_type(4)));
constexpr int BM = 256, BK = 64, HALF = 128, HTB = HALF * BK * 2  , STAGE_BYTES = 8 * HTB, NXCD = 8, WGM = 4;

__host__ __device__ __forceinline__ int lds_byte(int r, int c) { const int st = (r >> 4) * 2 + (c >> 5), rr = r & 15, cc = c & 31, ob = rr * 64 + cc * 2; return st * 1024 + (ob ^ (((ob >> 9) & 1) << 5)); }
__host__ __device__ __forceinline__ void stage_rc(int b, int& R, int& C) { const int st = b / 1024, sb = b % 1024, swz = sb ^ (((sb >> 9) & 1) << 5); R = (st >> 1) * 16 + swz / 64; C = (st & 1) * 32 + (swz % 64) / 2; }
__host__ __device__ __forceinline__ int perm32(int rho) { const int n = rho >> 4, i = rho & 15; return 8 * (i >> 2) + 4 * n + (i & 3); }

struct Unit { int pm, pn, k0, nt, si; };
struct Gemm { const bf16_t* A; const bf16_t* Bt; int M, N, K; };

struct StaticOrder {
    int nM, nN, nwg, G, c, ntk;
    __host__ __device__ void init(int M, int N, int K, int G_, int c_) { nM = M / BM; nN = N / BM; nwg = nM * nN; G = G_; c = c_; ntk = K / BK; }
    __host__ __device__ bool next(int i, Unit& u) const {
        const long L = (long)i * G + c; if (L >= nwg) return false;
        int wgid = (int)L; { const int q = nwg / NXCD, r = nwg % NXCD, xcd = wgid % NXCD, off = wgid / NXCD; wgid = (xcd < r ? xcd * (q + 1) : r * (q + 1) + (xcd - r) * q) + off; }
        const int nig = WGM * nN, gid = wgid / nig, fm = gid * WGM, gsz = (nM - fm) < WGM ? (nM - fm) : WGM;
        u.pm = fm + ((wgid % nig) % gsz); u.pn = (wgid % nig) / gsz; u.k0 = 0; u.nt = ntk; u.si = 0; return true;
    }
    __device__ __forceinline__ void a_ready(const Unit&) const {}
    __device__ __forceinline__ void done(const Unit&) const {}
};
struct ResidOrder {
    StaticOrder so; int ks, npairs;
    __host__ __device__ void init(int MPr, int N, int K, int G_, int c_, int ks_) { so.init(MPr, N, K, G_, c_); ks = ks_; npairs = K / (2 * BK); }
    __host__ __device__ bool next(int i, Unit& u) const {
        long L;
        if (so.G == so.nwg && so.c < 8 * ks) { if (i == 1) return so.next(0, u); if (i != 0) return false; L = so.c; }
        else { if (so.next(i, u)) return true; L = (long)i * so.G + so.c - so.nwg; if (L < 0 || L >= 8 * ks) return false; }
        const int j = (int)L, t = j / ks, s = j % ks, base = npairs / ks, rem = npairs % ks;
        u.pm = so.nM + (t >> 2); u.pn = t & 3; u.k0 = (s * base + (s < rem ? s : rem)) * 2 * BK; u.nt = 2 * (base + (s < rem ? 1 : 0)); u.si = s; return true;
    }
    __device__ __forceinline__ void a_ready(const Unit&) const {}
    __device__ __forceinline__ void done(const Unit&) const {}
};
struct SampleOrder {
    int nM0, nN, c, ntk;
    __host__ __device__ void init(int MPr, int N, int K, int c_) { nM0 = MPr / BM; nN = N / BM; c = c_; ntk = K / BK; }
    __host__ __device__ bool next(int i, Unit& u) const { if (i > 0 || c >= 2 * nN) return false; u.pm = nM0 + c / nN; u.pn = c % nN; u.k0 = 0; u.nt = ntk; u.si = 0; return true; }
    __device__ __forceinline__ void a_ready(const Unit&) const {}
    __device__ __forceinline__ void done(const Unit&) const {}
};
__device__ __forceinline__ unsigned cvt_pk_bf16(float lo, float hi) { unsigned r; asm volatile("v_cvt_pk_bf16_f32 %0, %1, %2" : "=v"(r) : "v"(lo), "v"(hi)); return r; }
typedef float f32x2 __attribute__((ext_vector_type(2)));
template <class Epi, class Sched, bool ALIGN_EPI = false, bool SP2 = false>
__device__ __forceinline__ void gemm_phase(PG8_LAS unsigned char* lds, const Gemm g, const Sched& S, const Epi& E) {
    const int tid = threadIdx.x, wid = __builtin_amdgcn_readfirstlane(tid >> 6), lane = tid & 63, wr = wid >> 2, wc = wid & 3, fr = lane & 15, fq = lane >> 4;
    const int K = g.K;
    unsigned voffA[2], voffB[2];
#pragma unroll
    for (int i = 0; i < 2; ++i) { int R, C; stage_rc(tid * 16 + i * 8192, R, C); const int Rb = Epi::PERM ? ((R & ~31) + perm32(R & 31)) : R;
        voffA[i] = (unsigned)(R * K + C) * 2u; voffB[i] = (unsigned)(Rb * K + C) * 2u; }
    const size_t kstep = (size_t)(BK * 2);
    const size_t hstep = (size_t)HALF * K * 2;
    const size_t tstep = 2 * hstep;
    const unsigned ldsw = (unsigned)wid * 1024u;
    const int aoff = lds_byte(wr * 64 + fr, fq * 8), boff = lds_byte(wc * 32 + fr, fq * 8);
#define PG8_SA(b, h) (((b) * 2 + (h)) * HTB)
#define PG8_SB(b, h) ((4 + (b) * 2 + (h)) * HTB)
#define PG8_STAGE(bufoff, gbase, voff) do { _Pragma("unroll") for (int _i = 0; _i < 2; ++_i) \
        __builtin_amdgcn_global_load_lds((const unsigned*)((const char*)(gbase) + (voff)[_i]), (PG8_LAS unsigned*)(lds + (bufoff) + ldsw + _i * 8192), 16, 0, 0); } while (0)
#define PG8_LDA(dst, b, h) do { _Pragma("unroll") for (int m = 0; m < 4; ++m) _Pragma("unroll") for (int k = 0; k < 2; ++k) dst[m][k] = *(const PG8_LAS bf16x8*)(lds + PG8_SA(b, h) + aoff + m * 2048 + k * 1024); } while (0)
#define PG8_LDB(dst, b, h) do { _Pragma("unroll") for (int n = 0; n < 2; ++n) _Pragma("unroll") for (int k = 0; k < 2; ++k) dst[n][k] = *(const PG8_LAS bf16x8*)(lds + PG8_SB(b, h) + boff + n * 2048 + k * 1024); } while (0)
#define PG8_MMA(ai, bj, At, Bt) do { __builtin_amdgcn_s_setprio(1); _Pragma("unroll") for (int m = 0; m < 4; ++m) _Pragma("unroll") for (int n = 0; n < 2; ++n) _Pragma("unroll") for (int k = 0; k < 2; ++k) \
        acc[ai][bj][m][n] = __builtin_amdgcn_mfma_f32_16x16x32_bf16(Bt[n][k], At[m][k], acc[ai][bj][m][n], 0, 0, 0); __builtin_amdgcn_s_setprio(0); } while (0)
#define PG8_WAIT_V(n) asm volatile("s_waitcnt vmcnt(" #n ")" ::: "memory")
#define PG8_WAIT_L(n) asm volatile("s_waitcnt lgkmcnt(" #n ")" ::: "memory")
#define PG8_BAR __builtin_amdgcn_s_barrier()
#define PG8_SCHED __builtin_amdgcn_sched_barrier(0)
    Unit cur, nxt; int ui = 0;
    if (!S.next(0, cur)) return;
    f32x4 acc[2][2][4][2];
#pragma unroll
    for (int a = 0; a < 2; ++a)
#pragma unroll
        for (int b = 0; b < 2; ++b)
#pragma unroll
            for (int m = 0; m < 4; ++m)
#pragma unroll
                for (int n = 0; n < 2; ++n) acc[a][b][m][n] = (f32x4){0.f, 0.f, 0.f, 0.f};
    bf16x8 At[4][2], B0[2][2], B1[2][2];
    const char* cA = (const char*)g.A + (size_t)cur.pm * tstep + (size_t)cur.k0 * 2; const char* cB = (const char*)g.Bt + (size_t)cur.pn * tstep + (size_t)cur.k0 * 2;
    S.a_ready(cur);
    if constexpr (SP2) {
        PG8_STAGE(PG8_SB(0, 0), cB, voffB); PG8_STAGE(PG8_SB(0, 1), cB + hstep, voffB); PG8_STAGE(PG8_SA(0, 0), cA, voffA); PG8_STAGE(PG8_SA(0, 1), cA + hstep, voffA);
        if (wr == 1) PG8_BAR;
        PG8_WAIT_V(2); PG8_BAR;
        PG8_STAGE(PG8_SB(1, 0), cB + kstep, voffB); PG8_STAGE(PG8_SA(1, 0), cA + kstep, voffA); PG8_STAGE(PG8_SB(1, 1), cB + hstep + kstep, voffB);
        PG8_WAIT_V(6); PG8_BAR;
    } else {
        PG8_STAGE(PG8_SB(0, 0), cB, voffB); PG8_STAGE(PG8_SA(0, 0), cA, voffA); PG8_STAGE(PG8_SB(0, 1), cB + hstep, voffB); PG8_STAGE(PG8_SA(0, 1), cA + hstep, voffA);
        if (wr == 1) PG8_BAR;
        PG8_WAIT_V(4); PG8_BAR;
        PG8_STAGE(PG8_SB(1, 0), cB + kstep, voffB); PG8_STAGE(PG8_SA(1, 0), cA + kstep, voffA); PG8_STAGE(PG8_SB(1, 1), cB + hstep + kstep, voffB);
        PG8_WAIT_V(6); PG8_BAR;
    }
    for (;;) {
        const bool has_next = S.next(ui + 1, nxt);
        const char* nA = has_next ? (const char*)g.A + (size_t)nxt.pm * tstep + (size_t)nxt.k0 * 2 : cA; const char* nB = has_next ? (const char*)g.Bt + (size_t)nxt.pn * tstep + (size_t)nxt.k0 * 2 : cB;
        const int nt = cur.nt;
        for (int t = 0; t < nt; t += 2) {
            const bool last = (t == nt - 2);
            const char* a1 = cA + (size_t)(t + 1) * kstep;
            const char* a2 = last ? nA : cA + (size_t)(t + 2) * kstep; const char* b2 = last ? nB : cB + (size_t)(t + 2) * kstep;
            const char* a3 = a2 + kstep; const char* b3 = b2 + kstep;
            if (last && has_next) S.a_ready(nxt);
            if constexpr (SP2) {
            PG8_LDB(B0, 0, 0); PG8_LDB(B1, 0, 1); PG8_SCHED; PG8_LDA(At, 0, 0); PG8_STAGE(PG8_SA(1, 1), a1 + hstep, voffA);
            PG8_WAIT_V(8); PG8_WAIT_L(0); PG8_BAR; PG8_MMA(0, 0, At, B0); PG8_MMA(0, 1, At, B1); PG8_BAR; PG8_SCHED;
            PG8_LDA(At, 0, 1); PG8_STAGE(PG8_SB(0, 0), b2, voffB); PG8_STAGE(PG8_SB(0, 1), b2 + hstep, voffB); PG8_STAGE(PG8_SA(0, 0), a2, voffA);
            PG8_WAIT_V(8); PG8_WAIT_L(0); PG8_BAR; PG8_MMA(1, 0, At, B0); PG8_MMA(1, 1, At, B1); PG8_BAR; PG8_SCHED;
            PG8_LDB(B0, 1, 0); PG8_LDB(B1, 1, 1); PG8_SCHED; PG8_LDA(At, 1, 0); PG8_STAGE(PG8_SA(0, 1), a2 + hstep, voffA);
            PG8_WAIT_V(8); PG8_WAIT_L(0); PG8_BAR; PG8_MMA(0, 0, At, B0); PG8_MMA(0, 1, At, B1); PG8_BAR; PG8_SCHED;
            PG8_LDA(At, 1, 1); PG8_STAGE(PG8_SB(1, 0), b3, voffB); PG8_STAGE(PG8_SB(1, 1), b3 + hstep, voffB); PG8_STAGE(PG8_SA(1, 0), a3, voffA);
            PG8_WAIT_V(8); PG8_WAIT_L(0); PG8_BAR; PG8_MMA(1, 0, At, B0); PG8_MMA(1, 1, At, B1); PG8_BAR; PG8_SCHED;
            } else {
            PG8_LDB(B0, 0, 0); PG8_SCHED; PG8_LDA(At, 0, 0); PG8_STAGE(PG8_SA(1, 1), a1 + hstep, voffA);
            PG8_WAIT_L(8); PG8_BAR; PG8_WAIT_L(0); PG8_MMA(0, 0, At, B0); PG8_BAR; PG8_SCHED;
            PG8_LDB(B1, 0, 1); PG8_STAGE(PG8_SB(0, 0), b2, voffB);
            PG8_BAR; PG8_WAIT_L(0); PG8_MMA(0, 1, At, B1); PG8_BAR;
            PG8_LDA(At, 0, 1); PG8_STAGE(PG8_SA(0, 0), a2, voffA);
            PG8_BAR; PG8_WAIT_L(0); PG8_MMA(1, 0, At, B0); PG8_BAR; PG8_SCHED;
            PG8_STAGE(PG8_SB(0, 1), b2 + hstep, voffB);
            PG8_WAIT_V(6); PG8_BAR; PG8_MMA(1, 1, At, B1); PG8_BAR;
            PG8_LDB(B0, 1, 0); PG8_SCHED; PG8_LDA(At, 1, 0); PG8_STAGE(PG8_SA(0, 1), a2 + hstep, voffA);
            PG8_WAIT_L(8); PG8_BAR; PG8_WAIT_L(0); PG8_MMA(0, 0, At, B0); PG8_BAR; PG8_SCHED;
            PG8_LDB(B1, 1, 1); PG8_STAGE(PG8_SB(1, 0), b3, voffB);
            PG8_BAR; PG8_WAIT_L(0); PG8_MMA(0, 1, At, B1); PG8_BAR;
            PG8_LDA(At, 1, 1); PG8_STAGE(PG8_SA(1, 0), a3, voffA);
            PG8_BAR; PG8_WAIT_L(0); PG8_MMA(1, 0, At, B0); PG8_BAR; PG8_SCHED;
            PG8_STAGE(PG8_SB(1, 1), b3 + hstep, voffB);
            PG8_WAIT_V(6); PG8_BAR; PG8_MMA(1, 1, At, B1); PG8_BAR;
            }
        }
        if constexpr (ALIGN_EPI) { if (wr == 0) PG8_BAR; }
        if constexpr (!Epi::AFTER_DRAIN) { E(acc, cur, wr, wc, fr, fq); S.done(cur); }
        if (!has_next) break;
#pragma unroll
        for (int a = 0; a < 2; ++a)
#pragma unroll
            for (int b = 0; b < 2; ++b)
#pragma unroll
                for (int m = 0; m < 4; ++m)
#pragma unroll
                    for (int n = 0; n < 2; ++n) acc[a][b][m][n] = (f32x4){0.f, 0.f, 0.f, 0.f};
        cur = nxt; cA = nA; cB = nB; ++ui;
        if constexpr (ALIGN_EPI) { if (wr == 1) PG8_BAR; }
    }
    PG8_WAIT_V(0);
    if constexpr (!ALIGN_EPI) { if (wr == 0) PG8_BAR; }
    PG8_BAR;
    if constexpr (Epi::AFTER_DRAIN) { E.fused(acc, cur, wr, wc, fr, fq, lds, wid, lane); S.done(cur); }
#undef PG8_SA
#undef PG8_SB
#undef PG8_STAGE
#undef PG8_LDA
#undef PG8_LDB
#undef PG8_MMA
#undef PG8_WAIT_V
#undef PG8_WAIT_L
#undef PG8_BAR
#undef PG8_SCHED
}
}

#ifndef PROBE_R0
#define PROBE_R0 1
#define PROBE_R1 1
#define PROBE_R2 1
#endif
#ifndef REPMASK
#define REPMASK 0
#endif
#ifndef MK_N_LAUNCHES
#define MK_N_LAUNCHES 1
#endif
constexpr int D = 1024, FF = 2816, MP = 16384, MS = 512, M = MP + MS, NIN = 3072, HW = 512;
constexpr int ADA_LD = 9216;
constexpr float EPS = 1e-6f;
constexpr float LOG2E = 1.4426950408889634f;
constexpr int NPHASE = 14;
constexpr size_t O_Y = 0, O_RSP = 17301504, O_CSP = 17825792, O_RSS = 17948672, O_CSS = 26337280;
constexpr size_t MiB = 1u << 20;
constexpr size_t WS_W1 = 1 * MiB, WS_WD1 = 12 * MiB, WS_WADA = 18 * MiB, WS_WIN = 36 * MiB, WS_WOUT = 42 * MiB, WS_W5 = 44 * MiB, WS_WD2 = 55 * MiB;
constexpr size_t WS_ADA = 61 * MiB, WS_SC = 70 * MiB, WS_ROPE = 71 * MiB, WS_H = 73 * MiB, WS_ACT = 106 * MiB, WS_L = 1 * MiB, WS_XB = 197 * MiB, WS_PART = 230 * MiB, WS_END = 252 * MiB;
constexpr size_t QKV_BYTES = (size_t)M * HW * 2;
constexpr int ROPE_N = 2052 * 64;
constexpr int LDS_BYTES = 147456, RING_BYTES = 131072;

#define LAS __attribute__((address_space(3)))
typedef unsigned short bf16_t;
typedef float f32x4 __attribute__((ext_vector_type(4)));
typedef float f32x2 __attribute__((ext_vector_type(2)));
typedef unsigned u32x4 __attribute__((ext_vector_type(4)));
typedef unsigned u32x2 __attribute__((ext_vector_type(2)));
typedef short bf16x8 __attribute__((ext_vector_type(8)));
using pg8::cvt_pk_bf16;

__device__ __forceinline__ float bf2f(unsigned v) { return __uint_as_float(v << 16); }
__device__ __forceinline__ float bflo(unsigned w) { return __uint_as_float(w << 16); }
__device__ __forceinline__ float bfhi(unsigned w) { return __uint_as_float(w & 0xffff0000u); }
__device__ __forceinline__ float sigm(float x) { return __builtin_amdgcn_rcpf(1.0f + __builtin_amdgcn_exp2f(-x * LOG2E)); }
__device__ __forceinline__ float silu(float x) { return x * sigm(x); }
__device__ __forceinline__ float wave_sum(float v) {
#pragma unroll
    for (int o = 1; o < 64; o <<= 1) v += __shfl_xor(v, o);
    return v;
}
__device__ __forceinline__ int ada_row(int r) { return r < MP ? (r >> 11) : 8 + ((r - MP) >> 2); }
__device__ __forceinline__ float lg2gamma(int h) { return h == 0 ? -0.04580368961312479f : h == 1 ? -0.02272007650008353f : h == 2 ? -0.011315313227834146f : -0.005646563141142063f; }

struct P {
    const float *xp, *xs, *cp, *cs, *state_ret, *state_conv, *norm1, *wg1, *wu1, *wd1, *normmix, *win, *gngain, *dww, *dwb, *lng, *lnb, *wout, *norm2, *wg2, *wu2, *wd2, *wada, *bada, *normf;
    float* out; unsigned char* ws;
    bf16_t *W1t, *Wd1t, *Wint, *Woutt, *W5t, *Wd2t, *Wadat, *SC, *H, *ACT, *Q, *K, *V, *G, *U;
    float *ada, *ropeC, *ropeS, *L, *PART; bf16_t* XB; bf16_t* SP;
};

namespace pg8 {
struct EpiSwiGLU { static constexpr bool PERM = true, AFTER_DRAIN = false;
    bf16_t* O;
    __device__ __forceinline__ void operator()(const f32x4 (&acc)[2][2][4][2], const Unit& u, int wr, int wc, int fr, int fq) const {
        const int row0 = u.pm * BM + wr * 64 + fr, col0 = u.pn * 128 + wc * 32 + 8 * fq;
#pragma unroll
        for (int ai = 0; ai < 2; ++ai)
#pragma unroll
            for (int m = 0; m < 4; ++m) {
                bf16_t* rowp = O + (size_t)(row0 + ai * HALF + m * 16) * FF + col0;
                const f32x4 g0 = acc[ai][0][m][0], g1 = acc[ai][0][m][1], u0 = acc[ai][1][m][0], u1 = acc[ai][1][m][1];
                u32x4 w;
                w.x = cvt_pk_bf16(silu(g0[0]) * u0[0], silu(g0[1]) * u0[1]); w.y = cvt_pk_bf16(silu(g0[2]) * u0[2], silu(g0[3]) * u0[3]);
                w.z = cvt_pk_bf16(silu(g1[0]) * u1[0], silu(g1[1]) * u1[1]); w.w = cvt_pk_bf16(silu(g1[2]) * u1[2], silu(g1[3]) * u1[3]);
                *(u32x4*)rowp = w;
            }
    }
};
template <bool RES_F32>
struct EpiResid { static constexpr bool PERM = true, AFTER_DRAIN = false;
    const float* rf; const bf16_t* rb; bf16_t* out; float* part; const float* gate; float scale;
    __device__ __forceinline__ void operator()(const f32x4 (&acc)[2][2][4][2], const Unit& u, int wr, int wc, int fr, int fq) const {
        const int col0 = u.pn * BM + wc * 32 + 8 * fq;
        if (u.pm < MP / BM) {
            const float* gp = gate + (size_t)(u.pm >> 3) * ADA_LD + col0;
            f32x4 gv[2][2];
#pragma unroll
            for (int bj = 0; bj < 2; ++bj)
#pragma unroll
                for (int n = 0; n < 2; ++n) gv[bj][n] = *(const f32x4*)(gp + bj * HALF + n * 4) * scale;
#pragma unroll
            for (int ai = 0; ai < 2; ++ai)
#pragma unroll
                for (int mp = 0; mp < 2; ++mp) {
                    const size_t off = (size_t)(u.pm * BM + ai * HALF + wr * 64 + mp * 32 + fr) * D + col0;
                    f32x4 rv[2][2][2];
                    if (RES_F32) {
#pragma unroll
                        for (int mm = 0; mm < 2; ++mm)
#pragma unroll
                            for (int bj = 0; bj < 2; ++bj)
#pragma unroll
                                for (int n = 0; n < 2; ++n) rv[mm][bj][n] = *(const f32x4*)(rf + off + (size_t)mm * 16 * D + bj * HALF + n * 4);
                    } else {
#pragma unroll
                        for (int mm = 0; mm < 2; ++mm)
#pragma unroll
                            for (int bj = 0; bj < 2; ++bj) { const u32x4 w = *(const u32x4*)(rb + off + (size_t)mm * 16 * D + bj * HALF);
                                rv[mm][bj][0] = (f32x4){bflo(w.x), bfhi(w.x), bflo(w.y), bfhi(w.y)}; rv[mm][bj][1] = (f32x4){bflo(w.z), bfhi(w.z), bflo(w.w), bfhi(w.w)}; }
                    }
#pragma unroll
                    for (int mm = 0; mm < 2; ++mm)
#pragma unroll
                        for (int bj = 0; bj < 2; ++bj) {
                            const f32x4 o0 = rv[mm][bj][0] + gv[bj][0] * acc[ai][bj][2 * mp + mm][0], o1 = rv[mm][bj][1] + gv[bj][1] * acc[ai][bj][2 * mp + mm][1];
                            u32x4 w; w.x = cvt_pk_bf16(o0[0], o0[1]); w.y = cvt_pk_bf16(o0[2], o0[3]); w.z = cvt_pk_bf16(o1[0], o1[1]); w.w = cvt_pk_bf16(o1[2], o1[3]);
                            *(u32x4*)(out + off + (size_t)mm * 16 * D + bj * HALF) = w;
                        }
                    asm volatile("" ::: "memory");
                }
        } else {
#pragma unroll
            for (int ai = 0; ai < 2; ++ai)
#pragma unroll
                for (int m = 0; m < 4; ++m) {
                    const int r = u.pm * BM + ai * HALF + wr * 64 + m * 16 + fr;
                    const float* gp = gate + (size_t)ada_row(r) * ADA_LD;
                    float* op = part + ((size_t)u.si * MS + (r - MP)) * D;
#pragma unroll
                    for (int bj = 0; bj < 2; ++bj)
#pragma unroll
                        for (int n = 0; n < 2; ++n) { const int col = col0 + bj * HALF + n * 4;
                            const f32x4 gv = *(const f32x4*)(gp + col); *(f32x4*)(op + col) = (gv * scale) * acc[ai][bj][m][n]; }
                }
        }
    }
};
struct EpiAda { static constexpr bool PERM = false, AFTER_DRAIN = false;
    float* out; const float* bias;
    __device__ __forceinline__ void operator()(const f32x4 (&acc)[2][2][4][2], const Unit& u, int wr, int wc, int fr, int fq) const {
        const int col0 = u.pn * BM + wc * 32 + 4 * fq;
#pragma unroll
        for (int ai = 0; ai < 2; ++ai)
#pragma unroll
            for (int m = 0; m < 4; ++m) {
                const int r = u.pm * BM + ai * HALF + wr * 64 + m * 16 + fr;
                float* op = out + (size_t)r * ADA_LD;
#pragma unroll
                for (int bj = 0; bj < 2; ++bj)
#pragma unroll
                    for (int n = 0; n < 2; ++n) { const int col = col0 + bj * HALF + n * 16;
                        *(f32x4*)(op + col) = acc[ai][bj][m][n] + *(const f32x4*)(bias + col); }
            }
    }
};
struct EpiMix { static constexpr bool PERM = true, AFTER_DRAIN = false;
    bf16_t *Q, *Kb, *V, *G, *U; const float* ropeC; const float* ropeS;
    __device__ __forceinline__ void operator()(const f32x4 (&acc)[2][2][4][2], const Unit& u, int wr, int wc, int fr, int fq) const {
        const int pn = u.pn, row0 = u.pm * BM + wr * 64 + fr;
        if (pn < 4) {
            const bool isk = pn >= 2; bf16_t* dstb = isk ? Kb : Q; const float sc = isk ? 0.08838834764831845f : 1.0f;
            const int head = 2 * (pn & 1) + (wc >> 1), d0 = 32 * (wc & 1) + 8 * fq;
#pragma unroll
            for (int ai = 0; ai < 2; ++ai)
#pragma unroll
              for (int mp = 0; mp < 2; ++mp) {
                f32x4 tc[2][2], ts[2][2];
#pragma unroll
                for (int mm = 0; mm < 2; ++mm) { const int r = row0 + ai * HALF + (2 * mp + mm) * 16; const int idx = r < MP ? (r & 2047) : 2048 + ((r - MP) & 3);
                    tc[mm][0] = *(const f32x4*)(ropeC + idx * 64 + d0); tc[mm][1] = *(const f32x4*)(ropeC + idx * 64 + d0 + 4);
                    ts[mm][0] = *(const f32x4*)(ropeS + idx * 64 + d0); ts[mm][1] = *(const f32x4*)(ropeS + idx * 64 + d0 + 4); }
#pragma unroll
                for (int mm = 0; mm < 2; ++mm) {
                    const int m = 2 * mp + mm;
                    const int r = row0 + ai * HALF + m * 16;
                    const f32x4 c0 = tc[mm][0], c1 = tc[mm][1], s0 = ts[mm][0], s1 = ts[mm][1];
                    const f32x4 a0 = acc[ai][0][m][0] * sc, a1 = acc[ai][0][m][1] * sc, b0 = acc[ai][1][m][0] * sc, b1 = acc[ai][1][m][1] * sc;
                    const f32x4 o10 = a0 * c0 - b0 * s0, o11 = a1 * c1 - b1 * s1, o20 = a0 * s0 + b0 * c0, o21 = a1 * s1 + b1 * c1;
                    bf16_t* dst = dstb + (size_t)r * HW + head * 128 + d0;
                    u32x4 w1, w2;
                    w1.x = cvt_pk_bf16(o10[0], o10[1]); w1.y = cvt_pk_bf16(o10[2], o10[3]); w1.z = cvt_pk_bf16(o11[0], o11[1]); w1.w = cvt_pk_bf16(o11[2], o11[3]);
                    w2.x = cvt_pk_bf16(o20[0], o20[1]); w2.y = cvt_pk_bf16(o20[2], o20[3]); w2.z = cvt_pk_bf16(o21[0], o21[1]); w2.w = cvt_pk_bf16(o21[2], o21[3]);
                    *(u32x4*)dst = w1; *(u32x4*)(dst + 64) = w2;
                }
              }
        } else if (pn < 8) {
            const bool isg = pn >= 6; bf16_t* dstb = isg ? G : V; const int colb = 256 * ((pn - 4) & 1) + wc * 32 + 8 * fq;
#pragma unroll
            for (int ai = 0; ai < 2; ++ai)
#pragma unroll
                for (int m = 0; m < 4; ++m) {
                    const int r = row0 + ai * HALF + m * 16;
#pragma unroll
                    for (int bj = 0; bj < 2; ++bj) {
                        f32x4 v0 = acc[ai][bj][m][0], v1 = acc[ai][bj][m][1];
                        if (isg) { v0 = (f32x4){silu(v0[0]), silu(v0[1]), silu(v0[2]), silu(v0[3])}; v1 = (f32x4){silu(v1[0]), silu(v1[1]), silu(v1[2]), silu(v1[3])}; }
                        u32x4 w; w.x = cvt_pk_bf16(v0[0], v0[1]); w.y = cvt_pk_bf16(v0[2], v0[3]); w.z = cvt_pk_bf16(v1[0], v1[1]); w.w = cvt_pk_bf16(v1[2], v1[3]);
                        *(u32x4*)(dstb + (size_t)r * HW + colb + bj * HALF) = w;
                    }
                }
        } else {
            const int colb = 128 * (pn - 8) + wc * 32 + 8 * fq;
#pragma unroll
            for (int ai = 0; ai < 2; ++ai)
#pragma unroll
                for (int m = 0; m < 4; ++m) {
                    const int r = row0 + ai * HALF + m * 16;
                    const f32x4 a0 = acc[ai][0][m][0], a1 = acc[ai][0][m][1], b0 = acc[ai][1][m][0], b1 = acc[ai][1][m][1];
                    u32x4 w;
                    w.x = cvt_pk_bf16(a0[0] * sigm(b0[0]), a0[1] * sigm(b0[1])); w.y = cvt_pk_bf16(a0[2] * sigm(b0[2]), a0[3] * sigm(b0[3]));
                    w.z = cvt_pk_bf16(a1[0] * sigm(b1[0]), a1[1] * sigm(b1[1])); w.w = cvt_pk_bf16(a1[2] * sigm(b1[2]), a1[3] * sigm(b1[3]));
                    *(u32x4*)(U + (size_t)r * HW + colb) = w;
                }
        }
    }
};
}

__device__ __forceinline__ int drow_gate(int n0) { return (n0 >> 7) * 256 + (n0 & 127); }
__device__ __forceinline__ int drow_win(int n0) {
    if (n0 < 1024) { const int sec = n0 >> 9, c = n0 & 511, head = c >> 7, d0 = c & 127, bj = d0 >> 6, d = d0 & 63; return sec * 512 + (head >> 1) * 256 + bj * 128 + (head & 1) * 64 + d; }
    if (n0 < 2048) return n0;
    const int c = n0 - 2048, bj = c >> 9, cc = c & 511; return 2048 + (cc >> 7) * 256 + bj * 128 + (cc & 127);
}
struct TrD { const float* src; bf16_t* dst; int N, K; };
__device__ __forceinline__ TrD tr_mk(const float* W, int K, int N, bf16_t* WT, int kind, int it) {
    const int nblk = N / 32, kb = it / nblk, n0 = 32 * (it % nblk);
    int dr = n0;
    if (kind == 1) dr = drow_gate(n0); else if (kind == 2) dr = drow_gate(n0) + 128; else if (kind == 3) dr = drow_win(n0);
    TrD d; d.src = W + (size_t)(64 * kb) * N + n0; d.dst = WT + (size_t)dr * K + 64 * kb; d.N = N; d.K = K; return d;
}
constexpr int I_GU = 16 * 88, I_DN = 44 * 32, I_IN = 16 * 96, I_OUT = 16 * 32, I_ADA = 16 * 288;
constexpr int TR_REST = 4 * I_GU + 2 * I_DN + I_IN + I_OUT;
__device__ __forceinline__ TrD tr_desc(const P& p, int part, int it) {
    if (part == 0) return tr_mk(p.wada, 1024, 9216, p.Wadat, 0, it);
    int r = it;
    if (r < I_GU) return tr_mk(p.wg1, 1024, FF, p.W1t, 1, r); r -= I_GU;
    if (r < I_GU) return tr_mk(p.wu1, 1024, FF, p.W1t, 2, r); r -= I_GU;
    if (r < I_DN) return tr_mk(p.wd1, FF, 1024, p.Wd1t, 0, r); r -= I_DN;
    if (r < I_IN) return tr_mk(p.win, 1024, NIN, p.Wint, 3, r); r -= I_IN;
    if (r < I_OUT) return tr_mk(p.wout, 1024, 1024, p.Woutt, 0, r); r -= I_OUT;
    if (r < I_GU) return tr_mk(p.wg2, 1024, FF, p.W5t, 1, r); r -= I_GU;
    if (r < I_GU) return tr_mk(p.wu2, 1024, FF, p.W5t, 2, r); r -= I_GU;
    return tr_mk(p.wd2, FF, 1024, p.Wd2t, 0, r);
}
__device__ __forceinline__ void tr_load(const TrD& d, f32x4 (&v)[8], int lane) {
#pragma unroll
    for (int i = 0; i < 8; ++i) v[i] = *(const f32x4*)(d.src + (size_t)((lane >> 3) + 8 * i) * d.N + 4 * (lane & 7));
}
__device__ __forceinline__ void tr_store(const TrD& d, const f32x4 (&v)[8], LAS float* scr, int lane) {
#pragma unroll
    for (int i = 0; i < 8; ++i) { LAS float* q = scr + ((lane >> 3) + 8 * i) * 33 + 4 * (lane & 7); q[0] = v[i][0]; q[1] = v[i][1]; q[2] = v[i][2]; q[3] = v[i][3]; }
    asm volatile("s_waitcnt lgkmcnt(0)" ::: "memory");
    const int c = lane & 7;
#pragma unroll
    for (int j = 0; j < 4; ++j) { const int n = (lane >> 3) + 8 * j; const LAS float* s = scr + (8 * c) * 33 + n;
        u32x4 o; o.x = cvt_pk_bf16(s[0 * 33], s[1 * 33]); o.y = cvt_pk_bf16(s[2 * 33], s[3 * 33]); o.z = cvt_pk_bf16(s[4 * 33], s[5 * 33]); o.w = cvt_pk_bf16(s[6 * 33], s[7 * 33]);
        *(u32x4*)(d.dst + (size_t)n * d.K + 8 * c) = o; }
    asm volatile("s_waitcnt lgkmcnt(0)" ::: "memory");
}
__device__ __forceinline__ void tr_run(const P& p, int part, int nitems, int gw, int NGW, LAS float* scr, int lane) {
    int it = gw; if (it >= nitems) return;
    TrD d = tr_desc(p, part, it); f32x4 v[8]; tr_load(d, v, lane);
    for (;;) {
        const int itn = it + NGW; const bool more = itn < nitems;
        TrD dn = d; f32x4 vn[8];
        if (more) { dn = tr_desc(p, part, itn); tr_load(dn, vn, lane); }
        tr_store(d, v, scr, lane);
        if (!more) break;
        d = dn; it = itn;
#pragma unroll
        for (int i = 0; i < 8; ++i) v[i] = vn[i];
    }
}
__device__ __forceinline__ void rope_table(const P& p, int gt, int NGT) {
    for (int g = gt; g < ROPE_N; g += NGT) {
        const int pi_ = g >> 6, d = g & 63; const int pos = pi_ < 2048 ? pi_ : 16384 + (pi_ - 2048);
        double inv = 1.0; for (int i = 0; i < d; ++i) inv *= 0.8659643233600653;
        const double ang = (double)pos * inv;
        const double k = __builtin_rint(ang * 0.15915494309189535);
        double x = __builtin_fma(-k, 6.283185307179586, ang); x = __builtin_fma(-k, 2.4492935982947064e-16, x);
        const double x2 = x * x;
        double s = 0.0, c = 0.0;
#pragma unroll
        for (int n = 14; n >= 1; --n) { s = (1.0 - s * x2 * (1.0 / ((2.0 * n) * (2.0 * n + 1.0)))); c = (1.0 - c * x2 * (1.0 / ((2.0 * n - 1.0) * (2.0 * n)))); }
        p.ropeC[g] = (float)c; p.ropeS[g] = (float)(s * x);
    }
}
__device__ __forceinline__ void prologue(const P& p, LAS unsigned char* lds, int tid, int G, int part, int b0) {
    const int lane = tid & 63, wave = tid >> 6;
    LAS float* scr = (LAS float*)(lds + wave * 16384);
    if (part == 1) {
        if ((int)blockIdx.x < b0) return;
        rope_table(p, ((int)blockIdx.x - b0) * 512 + tid, (G - b0) * 512);
        tr_run(p, 1, TR_REST, ((int)blockIdx.x - b0) * 8 + wave, (G - b0) * 8, scr, lane);
        return;
    }
    tr_run(p, 0, I_ADA, blockIdx.x * 8 + wave, G * 8, scr, lane);
    const int gt = blockIdx.x * 512 + tid, NGT = G * 512;
    for (int g = gt; g < 256 * 128; g += NGT) {
        const int row = g >> 7, c8 = (g & 127) * 8;
        u32x4 o = (u32x4){0u, 0u, 0u, 0u};
        if (row < 136) { const float* src = row < 8 ? p.cp + (size_t)row * D + c8 : p.cs + (size_t)(row - 8) * D + c8;
            const f32x4 a = *(const f32x4*)src, b = *(const f32x4*)(src + 4);
            o.x = cvt_pk_bf16(silu(a[0]), silu(a[1])); o.y = cvt_pk_bf16(silu(a[2]), silu(a[3])); o.z = cvt_pk_bf16(silu(b[0]), silu(b[1])); o.w = cvt_pk_bf16(silu(b[2]), silu(b[3])); }
        *(u32x4*)(p.SC + (size_t)row * D + c8) = o;
    }
}

template <bool FINAL>
__device__ __forceinline__ void norm_prompt_chunk_b(const bf16_t* x0, const f32x4 (&A)[4], const f32x4 (&B)[4], bf16_t* h0, float* y0, int lane) {
    u32x4 cur[2], nxt[2];
#pragma unroll
    for (int j = 0; j < 2; ++j) cur[j] = *(const u32x4*)(x0 + 8 * lane + 512 * j);
#pragma unroll 1
    for (int r = 0; r < 8; ++r) {
        if (r < 7) {
#pragma unroll
            for (int j = 0; j < 2; ++j) nxt[j] = *(const u32x4*)(x0 + (size_t)(r + 1) * D + 8 * lane + 512 * j);
        }
        f32x4 v[4]; float ss = 0.f;
#pragma unroll
        for (int j = 0; j < 2; ++j) { v[2 * j] = (f32x4){bflo(cur[j].x), bfhi(cur[j].x), bflo(cur[j].y), bfhi(cur[j].y)}; v[2 * j + 1] = (f32x4){bflo(cur[j].z), bfhi(cur[j].z), bflo(cur[j].w), bfhi(cur[j].w)}; }
#pragma unroll
        for (int j = 0; j < 4; ++j) ss += (v[j][0] * v[j][0] + v[j][1] * v[j][1]) + (v[j][2] * v[j][2] + v[j][3] * v[j][3]);
        const float rstd = 1.0f / sqrtf(wave_sum(ss) * (1.0f / D) + EPS);
#pragma unroll
        for (int j = 0; j < 2; ++j) {
            if (FINAL) { float* yp = y0 + (size_t)r * D + 8 * lane + 512 * j; *(f32x4*)yp = v[2 * j] * rstd * A[2 * j]; *(f32x4*)(yp + 4) = v[2 * j + 1] * rstd * A[2 * j + 1]; }
            else { const f32x4 h0v = v[2 * j] * rstd * A[2 * j] + B[2 * j], h1v = v[2 * j + 1] * rstd * A[2 * j + 1] + B[2 * j + 1];
                   u32x4 o; o.x = cvt_pk_bf16(h0v[0], h0v[1]); o.y = cvt_pk_bf16(h0v[2], h0v[3]); o.z = cvt_pk_bf16(h1v[0], h1v[1]); o.w = cvt_pk_bf16(h1v[2], h1v[3]);
                   *(u32x4*)(h0 + (size_t)r * D + 8 * lane + 512 * j) = o; }
        }
#pragma unroll
        for (int j = 0; j < 2; ++j) cur[j] = nxt[j];
    }
}
template <bool FINAL>
__device__ __forceinline__ void norm_prompt_chunk(const float* x0, const f32x4 (&A)[4], const f32x4 (&B)[4], bf16_t* h0, float* y0, int lane) {
    f32x4 cur[4], nxt[4];
#pragma unroll
    for (int j = 0; j < 4; ++j) cur[j] = ((const f32x4*)x0)[lane + 64 * j];
#pragma unroll 1
    for (int r = 0; r < 8; ++r) {
        if (r < 7) {
#pragma unroll
            for (int j = 0; j < 4; ++j) nxt[j] = ((const f32x4*)(x0 + (size_t)(r + 1) * D))[lane + 64 * j];
        }
        float ss = 0.f;
#pragma unroll
        for (int j = 0; j < 4; ++j) ss += (cur[j][0] * cur[j][0] + cur[j][1] * cur[j][1]) + (cur[j][2] * cur[j][2] + cur[j][3] * cur[j][3]);
        const float rstd = 1.0f / sqrtf(wave_sum(ss) * (1.0f / D) + EPS);
#pragma unroll
        for (int j = 0; j < 4; ++j) {
            if (FINAL) ((f32x4*)(y0 + (size_t)r * D))[lane + 64 * j] = cur[j] * rstd * A[j];
            else { const f32x4 h = cur[j] * rstd * A[j] + B[j]; u32x2 o; o.x = cvt_pk_bf16(h[0], h[1]); o.y = cvt_pk_bf16(h[2], h[3]);
                   *(u32x2*)(h0 + (size_t)r * D + 4 * (lane + 64 * j)) = o; }
        }
#pragma unroll
        for (int j = 0; j < 4; ++j) cur[j] = nxt[j];
    }
}
__device__ __forceinline__ void norm_mod_phase(const float* xp, const bf16_t* xb, const float* xs, float* xs_out, const float* part, int ks, const float* gn, const float* ada, int sh_idx, int sc_idx, bf16_t* H, int tid, int G) {
    const int lane = tid & 63, gw = blockIdx.x * 8 + (tid >> 6), NGW = G * 8;
    f32x4 g4[4];
#pragma unroll
    for (int j = 0; j < 4; ++j) g4[j] = *(const f32x4*)(gn + 4 * (lane + 64 * j));
    if (xp) for (int ch = gw; ch < MP / 8; ch += NGW) {
        const int m0 = ch * 8; const float* ar = ada + (size_t)(m0 >> 11) * ADA_LD;
        f32x4 A[4], B[4];
#pragma unroll
        for (int j = 0; j < 4; ++j) { const int col = 4 * (lane + 64 * j); A[j] = g4[j] * (*(const f32x4*)(ar + sc_idx * 1024 + col) + 1.0f); B[j] = *(const f32x4*)(ar + sh_idx * 1024 + col); }
        norm_prompt_chunk<false>(xp + (size_t)m0 * D, A, B, H + (size_t)m0 * D, nullptr, lane);
    }
    if (xb) for (int ch = gw; ch < MP / 8; ch += NGW) {
        const int m0 = ch * 8; const float* ar = ada + (size_t)(m0 >> 11) * ADA_LD;
        f32x4 A[4], B[4];
#pragma unroll
        for (int j = 0; j < 4; ++j) { const int col = 8 * lane + 512 * (j >> 1) + 4 * (j & 1);
            A[j] = *(const f32x4*)(gn + col) * (*(const f32x4*)(ar + sc_idx * 1024 + col) + 1.0f); B[j] = *(const f32x4*)(ar + sh_idx * 1024 + col); }
        norm_prompt_chunk_b<false>(xb + (size_t)m0 * D, A, B, H + (size_t)m0 * D, nullptr, lane);
    }
    for (int ms = gw; ms < MS; ms += NGW) {
        const float* xr = xs + (size_t)ms * D; const float* ar = ada + (size_t)(8 + (ms >> 2)) * ADA_LD;
        f32x4 v[4]; float ss = 0.f;
#pragma unroll
        for (int j = 0; j < 4; ++j) v[j] = ((const f32x4*)xr)[lane + 64 * j];
        if (ks > 0) {
            for (int s = 0; s < ks; ++s) { const f32x4* pr = (const f32x4*)(part + ((size_t)s * MS + ms) * D);
#pragma unroll
                for (int j = 0; j < 4; ++j) v[j] += pr[lane + 64 * j]; }
#pragma unroll
            for (int j = 0; j < 4; ++j) ((f32x4*)(xs_out + (size_t)ms * D))[lane + 64 * j] = v[j];
        }
#pragma unroll
        for (int j = 0; j < 4; ++j) ss += (v[j][0] * v[j][0] + v[j][1] * v[j][1]) + (v[j][2] * v[j][2] + v[j][3] * v[j][3]);
        const float rstd = 1.0f / sqrtf(wave_sum(ss) * (1.0f / D) + EPS);
#pragma unroll
        for (int j = 0; j < 4; ++j) { const int col = 4 * (lane + 64 * j);
            const f32x4 sc4 = *(const f32x4*)(ar + sc_idx * 1024 + col), sh4 = *(const f32x4*)(ar + sh_idx * 1024 + col);
            const f32x4 h = (v[j] * rstd * g4[j]) * (sc4 + 1.0f) + sh4;
            u32x2 o; o.x = cvt_pk_bf16(h[0], h[1]); o.y = cvt_pk_bf16(h[2], h[3]);
            *(u32x2*)(H + (size_t)(MP + ms) * D + col) = o; }
    }
}
__device__ __forceinline__ void final_norm_phase(float* x, const bf16_t* xb, const float* part, int ks, const float* gn, int tid, int G) {
    const int lane = tid & 63, gw = blockIdx.x * 8 + (tid >> 6), NGW = G * 8;
    f32x4 g4[4];
#pragma unroll
    for (int j = 0; j < 4; ++j) g4[j] = *(const f32x4*)(gn + 4 * (lane + 64 * j));
    { f32x4 A[4];
#pragma unroll
      for (int j = 0; j < 4; ++j) A[j] = *(const f32x4*)(gn + 8 * lane + 512 * (j >> 1) + 4 * (j & 1));
      for (int ch = gw; ch < MP / 8; ch += NGW) norm_prompt_chunk_b<true>(xb + (size_t)ch * 8 * D, A, A, nullptr, x + (size_t)ch * 8 * D, lane); }
    for (int ms = gw; ms < MS; ms += NGW) {
        float* xr = x + (size_t)(MP + ms) * D;
        f32x4 v[4]; float ss = 0.f;
#pragma unroll
        for (int j = 0; j < 4; ++j) v[j] = ((const f32x4*)xr)[lane + 64 * j];
        for (int s = 0; s < ks; ++s) { const f32x4* pr = (const f32x4*)(part + ((size_t)s * MS + ms) * D);
#pragma unroll
            for (int j = 0; j < 4; ++j) v[j] += pr[lane + 64 * j]; }
#pragma unroll
        for (int j = 0; j < 4; ++j) ss += (v[j][0] * v[j][0] + v[j][1] * v[j][1]) + (v[j][2] * v[j][2] + v[j][3] * v[j][3]);
        const float rstd = 1.0f / sqrtf(wave_sum(ss) * (1.0f / D) + EPS);
#pragma unroll
        for (int j = 0; j < 4; ++j) ((f32x4*)xr)[lane + 64 * j] = v[j] * rstd * g4[j];
    }
}

constexpr int VSTR = 132;
constexpr int SSTR = 136;
#define MFMA16(a, b, c) __builtin_amdgcn_mfma_f32_16x16x32_bf16((a), (b), (c), 0, 0, 0)
__device__ __forceinline__ int slot_j(int q, int e) { return 16 * (e >> 2) + 4 * q + (e & 3); }

struct Chunk { u32x4 v[4]; };
__device__ __forceinline__ Chunk chunk_load(const bf16_t* src, int tid) {
    const int j = tid >> 2, part = tid & 3; const bf16_t* s = src + (size_t)j * HW + part * 32; Chunk c;
#pragma unroll
    for (int i = 0; i < 4; ++i) c.v[i] = *(const u32x4*)(s + 8 * i);
    return c;
}
template <int STR>
__device__ __forceinline__ void chunk_store(const Chunk& c, LAS bf16_t* dst, int tid) {
    const int j = tid >> 2, part = tid & 3;
#pragma unroll
    for (int i = 0; i < 4; ++i) { LAS u32x2* d = (LAS u32x2*)(dst + j * STR + part * 32 + 8 * i); d[0] = (u32x2){c.v[i].x, c.v[i].y}; d[1] = (u32x2){c.v[i].z, c.v[i].w}; }
}
__device__ __forceinline__ void stage_chunk(const bf16_t* src, LAS bf16_t* dst, int tid, bool decay, float lg2) {
    const int j = tid >> 2, part = tid & 3;
    const bf16_t* s = src + (size_t)j * HW + part * 32;
    const float dec = decay ? __builtin_amdgcn_exp2f(lg2 * (float)(127 - j)) : 1.0f;
#pragma unroll
    for (int i = 0; i < 4; ++i) {
        u32x4 v = *(const u32x4*)(s + 8 * i);
        if (decay) { v.x = cvt_pk_bf16(bflo(v.x) * dec, bfhi(v.x) * dec); v.y = cvt_pk_bf16(bflo(v.y) * dec, bfhi(v.y) * dec); v.z = cvt_pk_bf16(bflo(v.z) * dec, bfhi(v.z) * dec); v.w = cvt_pk_bf16(bflo(v.w) * dec, bfhi(v.w) * dec); }
        LAS u32x2* d = (LAS u32x2*)(dst + j * VSTR + part * 32 + 8 * i);
        d[0] = (u32x2){v.x, v.y}; d[1] = (u32x2){v.z, v.w};
    }
}
__device__ __forceinline__ bf16x8 gather8(const LAS bf16_t* img, int jbase, int col, int q) {
    bf16x8 f;
#pragma unroll
    for (int e = 0; e < 8; ++e) f[e] = (short)img[(jbase + slot_j(q, e)) * VSTR + col];
    return f;
}

__device__ __forceinline__ void la_item(const P& p, LAS unsigned char* lds, int item, int tid) {
    const int c = item & 15, bh = item >> 4, h = bh & 3, b = bh >> 2;
    const int lane = tid & 63, w = __builtin_amdgcn_readfirstlane(tid >> 6), q = lane >> 4, i16 = lane & 15;
    LAS bf16_t* Ks = (LAS bf16_t*)lds; LAS bf16_t* Vs = Ks + 128 * VSTR;
    const size_t r0 = (size_t)b * 2048 + c * 128;
    stage_chunk(p.K + r0 * HW + h * 128, Ks, tid, true, lg2gamma(h));
    stage_chunk(p.V + r0 * HW + h * 128, Vs, tid, false, 0.f);
    __syncthreads();
    f32x4 acc[8];
#pragma unroll
    for (int n = 0; n < 8; ++n) acc[n] = (f32x4){0.f, 0.f, 0.f, 0.f};
#pragma unroll
    for (int kk = 0; kk < 4; ++kk) {
        const bf16x8 kf = gather8(Ks, 32 * kk, 16 * w + i16, q);
#pragma unroll
        for (int n = 0; n < 8; ++n) { const bf16x8 vf = gather8(Vs, 32 * kk, 16 * n + i16, q); acc[n] = MFMA16(vf, kf, acc[n]); }
    }
    float* Lo = p.L + (size_t)(bh * 16 + c) * 16384 + (16 * w + i16) * 128 + 4 * q;
#pragma unroll
    for (int n = 0; n < 8; ++n) *(f32x4*)(Lo + 16 * n) = acc[n];
    __syncthreads();
}

__device__ __forceinline__ void retb_item(const P& p, LAS unsigned char* lds, int b, int h, int c, int tid) {
    const int lane = tid & 63, w = __builtin_amdgcn_readfirstlane(tid >> 6), q = lane >> 4, i16 = lane & 15;
    LAS bf16_t* Vs = (LAS bf16_t*)lds; LAS bf16_t* St = Vs + 128 * VSTR; LAS bf16_t* Ks = St + 128 * SSTR;
    const int bh = b * 4 + h; const size_t r0 = (size_t)b * 2048 + c * 128;
    const float lg2 = lg2gamma(h), gC = __builtin_amdgcn_exp2f(lg2 * 128.0f);
    const Chunk vch = chunk_load(p.V + r0 * HW + h * 128, tid), kch = chunk_load(p.K + r0 * HW + h * 128, tid);
    const int row = (int)r0 + 16 * w + i16;
    bf16x8 Qf[4];
#pragma unroll
    for (int kd = 0; kd < 4; ++kd) Qf[kd] = *(const bf16x8*)(p.Q + (size_t)row * HW + h * 128 + 32 * kd + 8 * q);
    {
        const int dkg = tid >> 5, dvq = tid & 31;
        u32x2 sv[8];
#pragma unroll
        for (int r = 0; r < 8; ++r) sv[r] = (u32x2){0u, 0u};
        if (c > 0) { const bf16_t* sp = p.SP + ((size_t)bh * 16 + c) * 16384 + dkg * 128 + 4 * dvq;
#pragma unroll
            for (int r = 0; r < 8; ++r) sv[r] = *(const u32x2*)(sp + r * 2048); }
#pragma unroll
        for (int r = 0; r < 8; ++r) { LAS bf16_t* d = St + (4 * dvq) * SSTR + dkg + 16 * r;
            d[0] = (bf16_t)(sv[r].x & 0xffffu); d[SSTR] = (bf16_t)(sv[r].x >> 16); d[2 * SSTR] = (bf16_t)(sv[r].y & 0xffffu); d[3 * SSTR] = (bf16_t)(sv[r].y >> 16); }
    }
    chunk_store<VSTR>(vch, Vs, tid); chunk_store<SSTR>(kch, Ks, tid);
    __syncthreads();
    f32x4 acc[8];
#pragma unroll
    for (int n = 0; n < 8; ++n) acc[n] = (f32x4){0.f, 0.f, 0.f, 0.f};
#pragma unroll
    for (int n = 0; n < 8; ++n)
#pragma unroll
        for (int kd = 0; kd < 4; ++kd) { const bf16x8 sf = *(const LAS bf16x8*)(St + (16 * n + i16) * SSTR + 32 * kd + 8 * q); acc[n] = MFMA16(sf, Qf[kd], acc[n]); }
    const int ti = 16 * w + i16;
    { const float dq = __builtin_amdgcn_exp2f(lg2 * (float)(ti + 1));
#pragma unroll
      for (int n = 0; n < 8; ++n) acc[n] = acc[n] * dq; }
#pragma unroll
    for (int kb = 0; kb < 4; ++kb) {
        if (2 * kb <= w) {
            f32x4 st0 = (f32x4){0.f, 0.f, 0.f, 0.f}, st1 = (f32x4){0.f, 0.f, 0.f, 0.f};
            const LAS bf16_t* kp = Ks + (32 * kb + i16) * SSTR + 8 * q;
#pragma unroll
            for (int kd = 0; kd < 4; ++kd) { const bf16x8 kf = *(const LAS bf16x8*)(kp + 32 * kd); st0 = MFMA16(kf, Qf[kd], st0); }
            if (2 * kb + 1 <= w) {
#pragma unroll
                for (int kd = 0; kd < 4; ++kd) { const bf16x8 kf = *(const LAS bf16x8*)(kp + 16 * SSTR + 32 * kd); st1 = MFMA16(kf, Qf[kd], st1); }
            }
            float pv[8];
#pragma unroll
            for (int e = 0; e < 4; ++e) {
                const int j0 = 32 * kb + 4 * q + e, j1 = j0 + 16;
                const int d0 = ti - j0, d1 = ti - j1;
                pv[e] = d0 >= 0 ? st0[e] * __builtin_amdgcn_exp2f(lg2 * (float)d0) : 0.f;
                pv[4 + e] = d1 >= 0 ? st1[e] * __builtin_amdgcn_exp2f(lg2 * (float)d1) : 0.f;
            }
            u32x4 pw; pw.x = cvt_pk_bf16(pv[0], pv[1]); pw.y = cvt_pk_bf16(pv[2], pv[3]); pw.z = cvt_pk_bf16(pv[4], pv[5]); pw.w = cvt_pk_bf16(pv[6], pv[7]);
            const bf16x8 pf = __builtin_bit_cast(bf16x8, pw);
#pragma unroll
            for (int n = 0; n < 8; ++n) { const bf16x8 vf = gather8(Vs, 32 * kb, 16 * n + i16, q); acc[n] = MFMA16(vf, pf, acc[n]); }
        }
    }
    float s = 0.f;
#pragma unroll
    for (int n = 0; n < 8; ++n) s += (acc[n][0] + acc[n][1]) + (acc[n][2] + acc[n][3]);
    s += __shfl_xor(s, 16); s += __shfl_xor(s, 32);
    const float mean = s * (1.0f / 128.0f);
    float vq = 0.f;
#pragma unroll
    for (int n = 0; n < 8; ++n) { const f32x4 d = acc[n] - mean; vq += (d[0] * d[0] + d[1] * d[1]) + (d[2] * d[2] + d[3] * d[3]); }
    vq += __shfl_xor(vq, 16); vq += __shfl_xor(vq, 32);
    const float rstd = 1.0f / sqrtf(vq * (1.0f / 128.0f) + EPS);
    const bf16_t* gp = p.G + (size_t)row * HW + h * 128 + 4 * q;
    const float* gn = p.gngain + h * 128 + 4 * q;
    bf16_t* op = p.H + (size_t)row * D + h * 128 + 4 * q;
#pragma unroll
    for (int n = 0; n < 8; ++n) {
        const u32x2 gw = *(const u32x2*)(gp + 16 * n); const f32x4 g4 = *(const f32x4*)(gn + 16 * n);
        const f32x4 o = (acc[n] - mean) * rstd * g4;
        u32x2 ow; ow.x = cvt_pk_bf16(o[0] * bflo(gw.x), o[1] * bfhi(gw.x)); ow.y = cvt_pk_bf16(o[2] * bflo(gw.y), o[3] * bfhi(gw.y));
        *(u32x2*)(op + 16 * n) = ow;
    }
    __syncthreads();
}

__device__ __forceinline__ void scan_phase(const P& p, int tid, int G) {
    for (int e = blockIdx.x * 512 + tid; e < 32 * 4096; e += G * 512) {
        const int bh = e >> 12, o = (e & 4095) * 4;
        const float gC = __builtin_amdgcn_exp2f(lg2gamma(bh & 3) * 128.0f);
        const float* Lb = p.L + (size_t)bh * 16 * 16384 + o;
        f32x4 l[16];
#pragma unroll
        for (int c = 0; c < 16; ++c) l[c] = *(const f32x4*)(Lb + (size_t)c * 16384);
        f32x4 S = (f32x4){0.f, 0.f, 0.f, 0.f};
        bf16_t* sp = p.SP + (size_t)bh * 16 * 16384 + o;
#pragma unroll
        for (int c = 0; c < 15; ++c) { S = S * gC + l[c]; u32x2 w; w.x = cvt_pk_bf16(S[0], S[1]); w.y = cvt_pk_bf16(S[2], S[3]); *(u32x2*)(sp + (size_t)(c + 1) * 16384) = w; }
        *(f32x4*)(p.out + O_RSP + (size_t)bh * 16384 + o) = S * gC + l[15];
    }
}

__device__ __forceinline__ void sret_item(const P& p, LAS unsigned char* lds, int b, int h, int tid) {
    const int lane = tid & 63, w = __builtin_amdgcn_readfirstlane(tid >> 6);
    LAS float* qs = (LAS float*)lds; LAS float* ks = qs + 512; LAS float* vs = ks + 512; LAS float* os = vs + 512; LAS float* dots = os + 512; LAS float* red = dots + 64;
    const int r0 = MP + 4 * b; const float lg2 = lg2gamma(h);
    f32x4 s0v[8];
    { const float* S0p = p.state_ret + (size_t)(b * 4 + h) * 16384 + (tid >> 5) * 128 + 4 * (tid & 31);
#pragma unroll
      for (int r = 0; r < 8; ++r) s0v[r] = *(const f32x4*)(S0p + r * 2048); }
    { const int tok = tid >> 7, d = tid & 127; const size_t off = (size_t)(r0 + tok) * HW + h * 128 + d;
      qs[tid] = bf2f(p.Q[off]); ks[tid] = bf2f(p.K[off]); vs[tid] = bf2f(p.V[off]); }
    __syncthreads();
#pragma unroll
    for (int pp = 0; pp < 2; ++pp) { const int pr = 2 * w + pp, i = pr >> 2, j = pr & 3;
        float v = qs[i * 128 + lane] * ks[j * 128 + lane] + qs[i * 128 + lane + 64] * ks[j * 128 + lane + 64];
        v = wave_sum(v); if (lane == 0) dots[pr] = v; }
    const int dkg = tid >> 5, dvq = tid & 31;
    const float g1 = __builtin_amdgcn_exp2f(lg2), g2 = g1 * g1, g3 = g2 * g1, g4 = g2 * g2;
    float* Sn = p.out + O_RSS + (size_t)(b * 4 + h) * 16384 + dkg * 128 + 4 * dvq;
    const f32x4 v0 = *(const LAS f32x4*)(vs + 4 * dvq), v1 = *(const LAS f32x4*)(vs + 128 + 4 * dvq), v2 = *(const LAS f32x4*)(vs + 256 + 4 * dvq), v3 = *(const LAS f32x4*)(vs + 384 + 4 * dvq);
    f32x4 cr0 = (f32x4){0.f, 0.f, 0.f, 0.f}, cr1 = cr0, cr2 = cr0, cr3 = cr0;
#pragma unroll
    for (int r = 0; r < 8; ++r) { const int dk = dkg + 16 * r;
        const f32x4 s0 = s0v[r];
        cr0 += s0 * qs[dk]; cr1 += s0 * qs[128 + dk]; cr2 += s0 * qs[256 + dk]; cr3 += s0 * qs[384 + dk];
        const f32x4 sn = s0 * g4 + v0 * (ks[dk] * g3) + v1 * (ks[128 + dk] * g2) + v2 * (ks[256 + dk] * g1) + v3 * ks[384 + dk];
        *(f32x4*)(Sn + r * 2048) = sn; }
    *(LAS f32x4*)(red + (dkg * 4 + 0) * 128 + 4 * dvq) = cr0; *(LAS f32x4*)(red + (dkg * 4 + 1) * 128 + 4 * dvq) = cr1;
    *(LAS f32x4*)(red + (dkg * 4 + 2) * 128 + 4 * dvq) = cr2; *(LAS f32x4*)(red + (dkg * 4 + 3) * 128 + 4 * dvq) = cr3;
    __syncthreads();
    { const int i = tid >> 7, dv = tid & 127; float cs = 0.f;
#pragma unroll
      for (int g = 0; g < 16; ++g) cs += red[(g * 4 + i) * 128 + dv];
      float o = cs * __builtin_amdgcn_exp2f(lg2 * (float)(i + 1));
#pragma unroll
      for (int j = 0; j < 4; ++j) if (j <= i) o += __builtin_amdgcn_exp2f(lg2 * (float)(i - j)) * dots[i * 4 + j] * vs[j * 128 + dv];
      os[tid] = o; }
    __syncthreads();
    if (w < 4) { const float x0 = os[w * 128 + lane], x1 = os[w * 128 + lane + 64];
        const float mean = wave_sum(x0 + x1) * (1.0f / 128.0f); const float d0 = x0 - mean, d1 = x1 - mean;
        const float rstd = 1.0f / sqrtf(wave_sum(d0 * d0 + d1 * d1) * (1.0f / 128.0f) + EPS);
        const size_t row = (size_t)(r0 + w);
        const float ga = bf2f(p.G[row * HW + h * 128 + lane]), gb = bf2f(p.G[row * HW + h * 128 + lane + 64]);
        const float oa = d0 * rstd * p.gngain[h * 128 + lane] * ga, ob = d1 * rstd * p.gngain[h * 128 + lane + 64] * gb;
        p.H[row * D + h * 128 + lane] = (bf16_t)(cvt_pk_bf16(oa, 0.f) & 0xffffu); p.H[row * D + h * 128 + lane + 64] = (bf16_t)(cvt_pk_bf16(ob, 0.f) & 0xffffu); }
    __syncthreads();
}

template <bool sample>
__device__ __forceinline__ void conv_item(const P& p, LAS unsigned char* lds, int seq, int t0, int ntok, int tid) {
    const int lane = tid & 63, w = __builtin_amdgcn_readfirstlane(tid >> 6);
    LAS bf16_t* us = (LAS bf16_t*)lds;
    LAS float* ys = (LAS float*)(lds + 63488);
    const int rowbase = sample ? MP + 4 * seq : seq * 2048;
    const int nrows = ntok + 30;
    {
        u32x4 sv[8];
#pragma unroll
        for (int i = 0; i < 8; ++i) {
            const int rr = w + 8 * i, tau = t0 - 30 + rr, c8 = lane * 8;
            sv[i] = (u32x4){0u, 0u, 0u, 0u};
            if (rr < nrows) {
                if (tau >= 0) sv[i] = *(const u32x4*)(p.U + (size_t)(rowbase + tau) * HW + c8);
                else if (sample) { const float* s = p.state_conv + ((size_t)seq * 30 + (30 + tau)) * HW + c8; const f32x4 a = *(const f32x4*)s, b = *(const f32x4*)(s + 4);
                    sv[i].x = cvt_pk_bf16(a[0], a[1]); sv[i].y = cvt_pk_bf16(a[2], a[3]); sv[i].z = cvt_pk_bf16(b[0], b[1]); sv[i].w = cvt_pk_bf16(b[2], b[3]); }
            }
        }
#pragma unroll
        for (int i = 0; i < 8; ++i) { const int rr = w + 8 * i; if (rr < nrows) *(LAS u32x4*)(us + rr * 512 + lane * 8) = sv[i]; }
    }
    __syncthreads();
    if (!sample) {
        const int c2 = 2 * (tid & 255), half = tid >> 8;
        f32x2 wk[31];
        { const float* wp = p.dww + c2;
#pragma unroll
          for (int k = 0; k < 31; ++k) { asm volatile("" : "+v"(wp)); wk[k] = *(const f32x2*)wp; wp += HW; } }
        const f32x2 bias = *(const f32x2*)(p.dwb + c2);
        f32x2 ya[16];
#pragma unroll
        for (int t = 0; t < 16; ++t) ya[t] = bias;
        const LAS bf16_t* ub = us + (16 * half) * 512 + c2;
#pragma unroll
        for (int i = 0; i < 46; ++i) {
            const unsigned uw = *(const LAS unsigned*)(ub + i * 512);
            const f32x2 u = (f32x2){bflo(uw), bfhi(uw)};
#pragma unroll
            for (int t = 0; t < 16; ++t) { if (i - t >= 0 && i - t <= 30) ya[t] += wk[i - t] * u; }
        }
#pragma unroll
        for (int t = 0; t < 16; ++t) *(LAS f32x2*)(ys + (16 * half + t) * 512 + c2) = ya[t];
        if (t0 == 2016) { const int c = tid; float* o = p.out + O_CSP + (size_t)seq * 30 * HW + c;
            for (int j = 0; j < 30; ++j) o[j * HW] = bf2f(us[(32 + j) * 512 + c]); }
    } else {
        const int c = tid;
        float wk[31];
        { const float* wp = p.dww + c;
#pragma unroll
          for (int k = 0; k < 31; ++k) { asm volatile("" : "+v"(wp)); wk[k] = *wp; wp += HW; } }
        const float bias = p.dwb[c];
        for (int tok = 0; tok < ntok; ++tok) {
            float y = bias;
#pragma unroll
            for (int k = 0; k < 31; ++k) y += wk[k] * bf2f(us[(tok + k) * 512 + c]);
            ys[tok * 512 + c] = y;
        }
        { float* o = p.out + O_CSS + (size_t)seq * 30 * HW + c; const float* sc = p.state_conv + (size_t)seq * 30 * HW + c;
            float tv[30];
#pragma unroll
            for (int j = 0; j < 30; ++j) { const int rr = j + 4; tv[j] = rr < 30 ? sc[rr * HW] : bf2f(us[rr * 512 + c]); }
#pragma unroll
            for (int j = 0; j < 30; ++j) o[j * HW] = tv[j]; }
    }
    __syncthreads();
#pragma unroll
    for (int ti_ = 0; ti_ < 4; ++ti_) {
        const int tok = w + 8 * ti_; if (tok >= ntok) break;
        const int c8 = lane * 8;
        const f32x4 a = *(const LAS f32x4*)(ys + tok * 512 + c8), b = *(const LAS f32x4*)(ys + tok * 512 + c8 + 4);
        const float mean = wave_sum((a[0] + a[1]) + (a[2] + a[3]) + (b[0] + b[1]) + (b[2] + b[3])) * (1.0f / 512.0f);
        const f32x4 da = a - mean, db = b - mean;
        const float var = wave_sum((da[0] * da[0] + da[1] * da[1]) + (da[2] * da[2] + da[3] * da[3]) + (db[0] * db[0] + db[1] * db[1]) + (db[2] * db[2] + db[3] * db[3])) * (1.0f / 512.0f);
        const float rstd = 1.0f / sqrtf(var + EPS);
        const f32x4 ga = *(const f32x4*)(p.lng + c8), gb = *(const f32x4*)(p.lng + c8 + 4), ba = *(const f32x4*)(p.lnb + c8), bb = *(const f32x4*)(p.lnb + c8 + 4);
        const f32x4 ya = da * rstd * ga + ba, yb = db * rstd * gb + bb;
        u32x4 o; o.x = cvt_pk_bf16(silu(ya[0]), silu(ya[1])); o.y = cvt_pk_bf16(silu(ya[2]), silu(ya[3])); o.z = cvt_pk_bf16(silu(yb[0]), silu(yb[1])); o.w = cvt_pk_bf16(silu(yb[2]), silu(yb[3]));
        *(u32x4*)(p.H + (size_t)(rowbase + t0 + tok) * D + 512 + c8) = o;
    }
    __syncthreads();
}


__device__ __forceinline__ void la_items(const P& p, LAS unsigned char* lds, int a0, int a1, int tid) {
    if (a0 >= a1) return;
    const int lane = tid & 63, w = __builtin_amdgcn_readfirstlane(tid >> 6), q = lane >> 4, i16 = lane & 15;
    LAS bf16_t* Ks = (LAS bf16_t*)lds; LAS bf16_t* Vs = Ks + 128 * VSTR;
    const int j = tid >> 2, part = tid & 3;
    Chunk kc, vc;
    { const int c = a0 & 15, bh = a0 >> 4, h = bh & 3, b = bh >> 2; const size_t r0 = (size_t)b * 2048 + c * 128;
      kc = chunk_load(p.K + r0 * HW + h * 128, tid); vc = chunk_load(p.V + r0 * HW + h * 128, tid); }
    for (int a = a0; a < a1; ++a) {
        const int c = a & 15, bh = a >> 4, h = bh & 3;
        { const float dec = __builtin_amdgcn_exp2f(lg2gamma(h) * (float)(127 - j));
#pragma unroll
          for (int i = 0; i < 4; ++i) { u32x4 v = kc.v[i];
              v.x = cvt_pk_bf16(bflo(v.x) * dec, bfhi(v.x) * dec); v.y = cvt_pk_bf16(bflo(v.y) * dec, bfhi(v.y) * dec); v.z = cvt_pk_bf16(bflo(v.z) * dec, bfhi(v.z) * dec); v.w = cvt_pk_bf16(bflo(v.w) * dec, bfhi(v.w) * dec);
              LAS u32x2* d = (LAS u32x2*)(Ks + j * VSTR + part * 32 + 8 * i); d[0] = (u32x2){v.x, v.y}; d[1] = (u32x2){v.z, v.w}; } }
        chunk_store<VSTR>(vc, Vs, tid);
        const bool more = a + 1 < a1; Chunk kn = kc, vn = vc;
        if (more) { const int cn = (a + 1) & 15, bhn = (a + 1) >> 4, hn = bhn & 3, bn = bhn >> 2; const size_t r0n = (size_t)bn * 2048 + cn * 128;
            kn = chunk_load(p.K + r0n * HW + hn * 128, tid); vn = chunk_load(p.V + r0n * HW + hn * 128, tid); }
        __syncthreads();
        f32x4 acc[8];
#pragma unroll
        for (int n = 0; n < 8; ++n) acc[n] = (f32x4){0.f, 0.f, 0.f, 0.f};
#pragma unroll
        for (int kk = 0; kk < 4; ++kk) {
            const bf16x8 kf = gather8(Ks, 32 * kk, 16 * w + i16, q);
#pragma unroll
            for (int n = 0; n < 8; ++n) { const bf16x8 vf = gather8(Vs, 32 * kk, 16 * n + i16, q); acc[n] = MFMA16(vf, kf, acc[n]); }
        }
        float* Lo = p.L + (size_t)(bh * 16 + c) * 16384 + (16 * w + i16) * 128 + 4 * q;
#pragma unroll
        for (int n = 0; n < 8; ++n) *(f32x4*)(Lo + 16 * n) = acc[n];
        __syncthreads();
        kc = kn; vc = vn;
    }
}
__device__ __forceinline__ void conv_rows_load(const P& p, int ci, u32x4 (&sv)[8], int w, int lane) {
    const int seq = ci >> 6, t0 = (ci & 63) * 32, rowbase = seq * 2048;
#pragma unroll
    for (int i = 0; i < 8; ++i) { const int rr = w + 8 * i, tau = t0 - 30 + rr;
        sv[i] = (u32x4){0u, 0u, 0u, 0u};
        if (rr < 62 && tau >= 0) sv[i] = *(const u32x4*)(p.U + (size_t)(rowbase + tau) * HW + lane * 8); }
}
__device__ __forceinline__ void conv_items(const P& p, LAS unsigned char* lds, int a0, int a1, int tid) {
    if (a0 >= a1) return;
    const int lane = tid & 63, w = __builtin_amdgcn_readfirstlane(tid >> 6);
    LAS bf16_t* us = (LAS bf16_t*)lds;
    LAS float* ys = (LAS float*)(lds + 63488);
    const int c2 = 2 * (tid & 255), half = tid >> 8;
    f32x2 wk[31];
    { const float* wp = p.dww + c2;
#pragma unroll
      for (int k = 0; k < 31; ++k) { asm volatile("" : "+v"(wp)); wk[k] = *(const f32x2*)wp; wp += HW; } }
    const f32x2 bias = *(const f32x2*)(p.dwb + c2);
    u32x4 sv[8]; conv_rows_load(p, a0, sv, w, lane);
    for (int ci = a0; ci < a1; ++ci) {
        const int seq = ci >> 6, t0 = (ci & 63) * 32, rowbase = seq * 2048;
#pragma unroll
        for (int i = 0; i < 8; ++i) { const int rr = w + 8 * i; if (rr < 62) *(LAS u32x4*)(us + rr * 512 + lane * 8) = sv[i]; }
        const bool more = ci + 1 < a1;
        if (more) conv_rows_load(p, ci + 1, sv, w, lane);
        __syncthreads();
        {
            f32x2 ya[16];
#pragma unroll
            for (int t = 0; t < 16; ++t) ya[t] = bias;
            const LAS bf16_t* ub = us + (16 * half) * 512 + c2;
#pragma unroll
            for (int i = 0; i < 46; ++i) {
                const unsigned uw = *(const LAS unsigned*)(ub + i * 512);
                const f32x2 u = (f32x2){bflo(uw), bfhi(uw)};
#pragma unroll
                for (int t = 0; t < 16; ++t) { if (i - t >= 0 && i - t <= 30) ya[t] += wk[i - t] * u; }
            }
#pragma unroll
            for (int t = 0; t < 16; ++t) *(LAS f32x2*)(ys + (16 * half + t) * 512 + c2) = ya[t];
            if (t0 == 2016) { const int c = tid; float* o = p.out + O_CSP + (size_t)seq * 30 * HW + c;
                for (int jj = 0; jj < 30; ++jj) o[jj * HW] = bf2f(us[(32 + jj) * 512 + c]); }
        }
        __syncthreads();
#pragma unroll
        for (int ti_ = 0; ti_ < 4; ++ti_) {
            const int tok = w + 8 * ti_; const int c8 = lane * 8;
            const f32x4 a = *(const LAS f32x4*)(ys + tok * 512 + c8), b = *(const LAS f32x4*)(ys + tok * 512 + c8 + 4);
            const float mean = wave_sum((a[0] + a[1]) + (a[2] + a[3]) + (b[0] + b[1]) + (b[2] + b[3])) * (1.0f / 512.0f);
            const f32x4 da = a - mean, db = b - mean;
            const float var = wave_sum((da[0] * da[0] + da[1] * da[1]) + (da[2] * da[2] + da[3] * da[3]) + (db[0] * db[0] + db[1] * db[1]) + (db[2] * db[2] + db[3] * db[3])) * (1.0f / 512.0f);
            const float rstd = 1.0f / sqrtf(var + EPS);
            const f32x4 ga = *(const f32x4*)(p.lng + c8), gb = *(const f32x4*)(p.lng + c8 + 4), ba = *(const f32x4*)(p.lnb + c8), bb = *(const f32x4*)(p.lnb + c8 + 4);
            const f32x4 yq = da * rstd * ga + ba, yb = db * rstd * gb + bb;
            u32x4 o; o.x = cvt_pk_bf16(silu(yq[0]), silu(yq[1])); o.y = cvt_pk_bf16(silu(yq[2]), silu(yq[3])); o.z = cvt_pk_bf16(silu(yb[0]), silu(yb[1])); o.w = cvt_pk_bf16(silu(yb[2]), silu(yb[3]));
            *(u32x4*)(p.H + (size_t)(rowbase + t0 + tok) * D + 512 + c8) = o;
        }
        __syncthreads();
    }
}

#define XB_TMO      128
#define XB_XCNT(j)  (256  + 64 * (j))
#define XB_XSUB(j)  (1280 + 64 * (j))
#define XB_XGEN(j)  (2304 + 64 * (j))
#define XB_TOP      3328
#define XB_TOPGEN   3392
#define XCD_BAR_WORDS 3456
#define XB_SPIN_CAP (1u << 18)

__device__ __forceinline__ unsigned xb_ld(unsigned* p)              { return __hip_atomic_load(p, __ATOMIC_RELAXED, __HIP_MEMORY_SCOPE_AGENT); }
__device__ __forceinline__ unsigned xb_add(unsigned* p, unsigned v) { return __hip_atomic_fetch_add(p, v, __ATOMIC_RELAXED, __HIP_MEMORY_SCOPE_AGENT); }
__device__ __forceinline__ unsigned xb_xcc_id() { return (unsigned)__builtin_amdgcn_s_getreg((3 << 11) | 20) & 0xFu; }
#define XB_SPIN(cond, bar) do { unsigned _sp = 0; while (cond) { __builtin_amdgcn_s_sleep(1); \
    if ((++_sp & 255u) == 0u) { if (xb_ld(&(bar)[XB_TMO])) break; if (_sp > XB_SPIN_CAP) { atomicAdd(&(bar)[XB_TMO], 1u); break; } } } } while (0)

struct XcdBarrier {
    unsigned* bar; unsigned x;
    volatile LAS unsigned* st;
};

__device__ __forceinline__ XcdBarrier xcd_barrier_post(unsigned* bar, volatile LAS unsigned* st) {
    XcdBarrier b; b.bar = bar; b.x = xb_xcc_id(); b.st = st;
    if (threadIdx.x == 0) (void)xb_add(&bar[XB_XCNT(b.x)], 1u);
    return b;
}
__device__ __forceinline__ void xcd_barrier_complete(unsigned* bar, unsigned x, unsigned& nloc, unsigned& nx) {
    const unsigned G = gridDim.x * gridDim.y * gridDim.z;
    unsigned sum, cnt, mine, sp = 0u;
    for (;;) {
        sum = 0u; cnt = 0u; mine = 0u;
#pragma unroll
        for (unsigned j = 0; j < 16; ++j) { const unsigned c = xb_ld(&bar[XB_XCNT(j)]); sum += c; cnt += (c > 0u) ? 1u : 0u; mine = (j == x) ? c : mine; }
        if (sum == G) break;
        __builtin_amdgcn_s_sleep(1);
        if ((++sp & 255u) == 0u) { if (xb_ld(&bar[XB_TMO])) break; if (sp > XB_SPIN_CAP) { atomicAdd(&bar[XB_TMO], 1u); break; } }
    }
    nloc = mine > 0u ? mine : 1u; nx = cnt > 0u ? cnt : 1u;
}

__device__ __forceinline__ void xcd_barrier(const XcdBarrier& b) {
    asm volatile("s_waitcnt vmcnt(0)" ::: "memory");
    __syncthreads();
    if (threadIdx.x == 0) {
        unsigned* bar = b.bar;
        __builtin_amdgcn_s_waitcnt(0);
        unsigned nloc = b.st[0], nx = b.st[1];
        if (nloc == 0u) { xcd_barrier_complete(bar, b.x, nloc, nx); b.st[0] = nloc; b.st[1] = nx; }
        const unsigned old = xb_add(&bar[XB_XSUB(b.x)], 1u);
        const unsigned gen = old / nloc;
        if (old + 1u == (gen + 1u) * nloc) {
            __builtin_amdgcn_fence(__ATOMIC_RELEASE, "agent");
            asm volatile("s_waitcnt vmcnt(0)" ::: "memory");
            const unsigned og = xb_add(&bar[XB_TOP], 1u);
            const unsigned tg = og / nx;
            if (og + 1u == (tg + 1u) * nx) xb_add(&bar[XB_TOPGEN], 1u);
            else XB_SPIN(xb_ld(&bar[XB_TOPGEN]) == tg, bar);
            __builtin_amdgcn_fence(__ATOMIC_ACQUIRE, "agent");
            xb_add(&bar[XB_XGEN(b.x)], 1u);
            asm volatile("s_waitcnt vmcnt(0)" ::: "memory");
        } else {
            XB_SPIN(xb_ld(&bar[XB_XGEN(b.x)]) == gen, bar);
            __builtin_amdgcn_fence(__ATOMIC_ACQUIRE, "agent");
            asm volatile("s_waitcnt vmcnt(0)" ::: "memory");
        }
    }
    __syncthreads();
}

struct Args { const float* in[25]; float* out; unsigned char* ws; int ph_lo, ph_hi; int rep[4]; };
__global__ void __launch_bounds__(512, 2) fwd_kernel(Args args) {
    extern __shared__ __attribute__((aligned(16))) unsigned char lds_raw[];
    LAS unsigned char* lds = (LAS unsigned char*)lds_raw;
    cg::grid_group grid = cg::this_grid();
    const int tid = threadIdx.x, G = gridDim.x;
    if (tid < 64) ((LAS unsigned*)(lds + RING_BYTES))[tid] = 0u;
    __syncthreads();
    XcdBarrier bar = xcd_barrier_post((unsigned*)args.ws + 1024, (volatile LAS unsigned*)(lds + RING_BYTES) + 8);
    P p;
    p.xp = args.in[0]; p.xs = args.in[1]; p.cp = args.in[2]; p.cs = args.in[3]; p.state_ret = args.in[4]; p.state_conv = args.in[5];
    p.norm1 = args.in[6]; p.wg1 = args.in[7]; p.wu1 = args.in[8]; p.wd1 = args.in[9]; p.normmix = args.in[10]; p.win = args.in[11]; p.gngain = args.in[12];
    p.dww = args.in[13]; p.dwb = args.in[14]; p.lng = args.in[15]; p.lnb = args.in[16]; p.wout = args.in[17]; p.norm2 = args.in[18];
    p.wg2 = args.in[19]; p.wu2 = args.in[20]; p.wd2 = args.in[21]; p.wada = args.in[22]; p.bada = args.in[23]; p.normf = args.in[24];
    p.out = args.out; p.ws = args.ws;
    unsigned char* ws = args.ws;
    p.W1t = (bf16_t*)(ws + WS_W1); p.Wd1t = (bf16_t*)(ws + WS_WD1); p.Wint = (bf16_t*)(ws + WS_WIN); p.Woutt = (bf16_t*)(ws + WS_WOUT);
    p.W5t = (bf16_t*)(ws + WS_W5); p.Wd2t = (bf16_t*)(ws + WS_WD2); p.Wadat = (bf16_t*)(ws + WS_WADA); p.SC = (bf16_t*)(ws + WS_SC);
    p.H = (bf16_t*)(ws + WS_H); p.ACT = (bf16_t*)(ws + WS_ACT);
    p.Q = (bf16_t*)(ws + WS_ACT); p.K = (bf16_t*)(ws + WS_ACT + QKV_BYTES); p.V = (bf16_t*)(ws + WS_ACT + 2 * QKV_BYTES); p.G = (bf16_t*)(ws + WS_ACT + 3 * QKV_BYTES); p.U = (bf16_t*)(ws + WS_ACT + 4 * QKV_BYTES);
    p.ada = (float*)(ws + WS_ADA); p.ropeC = (float*)(ws + WS_ROPE); p.ropeS = p.ropeC + ROPE_N; p.L = (float*)(ws + WS_L); p.PART = (float*)(ws + WS_PART); p.XB = (bf16_t*)(ws + WS_XB); p.SP = (bf16_t*)(ws + WS_PART);
    float* X = p.out + O_Y;

    const int lo = args.ph_lo, hi = args.ph_hi;
#define IN(k) (lo <= (k) && (k) < hi)
#define SEAM(k) do { if (IN(k) && IN((k) + 1)) xcd_barrier(bar); } while (0)
    if (args.ph_lo < 0) grid.sync();

#define PH_0 do { prologue(p, lds, tid, G, 0, 0); } while (0)
#define PH_1 do { \
        pg8::Gemm g{p.SC, p.Wadat, 256, 9216, 1024}; pg8::StaticOrder S; S.init(256, 9216, 1024, G, (int)blockIdx.x); \
        pg8::EpiAda E{p.ada, p.bada}; \
        pg8::gemm_phase<pg8::EpiAda, pg8::StaticOrder, true, true>(lds, g, S, E); \
        prologue(p, lds, tid, G, 1, G > 72 ? 36 : 0); \
    } while (0)
#define PH_2 do { norm_mod_phase(p.xp, nullptr, p.xs, nullptr, nullptr, 0, p.norm1, p.ada, 0, 1, p.H, tid, G); } while (0)
#define PH_3 do { \
        pg8::Gemm g{p.H, p.W1t, M, 2 * FF, 1024}; pg8::StaticOrder S; S.init(M, 2 * FF, 1024, G, (int)blockIdx.x); \
        pg8::EpiSwiGLU E{p.ACT}; \
        pg8::gemm_phase<pg8::EpiSwiGLU, pg8::StaticOrder, true, true>(lds, g, S, E); \
    } while (0)
#define PH_4 do { \
        pg8::Gemm g{p.ACT, p.Wd1t, M, 1024, FF}; pg8::ResidOrder S; S.init(MP, 1024, FF, G, (int)blockIdx.x, 11); \
        pg8::EpiResid<true> E{p.xp, nullptr, p.XB, p.PART, p.ada + 2 * 1024, 0.5f}; \
        pg8::gemm_phase<pg8::EpiResid<true>, pg8::ResidOrder, true, true>(lds, g, S, E); \
    } while (0)
#define PH_5 do { norm_mod_phase(nullptr, p.XB, p.xs, X + (size_t)MP * D, p.PART, 11, p.normmix, p.ada, 3, 4, p.H, tid, G); } while (0)
#define PH_6 do { \
        pg8::Gemm g{p.H, p.Wint, M, NIN, 1024}; pg8::StaticOrder S; S.init(MP, NIN, 1024, G, (int)blockIdx.x); \
        pg8::EpiMix E{p.Q, p.K, p.V, p.G, p.U, p.ropeC, p.ropeS}; \
        pg8::gemm_phase<pg8::EpiMix, pg8::StaticOrder, true, true>(lds, g, S, E); \
    } while (0)
#define PH_7 do { \
        const int nb0 = G > 48 ? 24 : 0; \
        if ((int)blockIdx.x < 24) { \
            pg8::Gemm g{p.H, p.Wint, M, NIN, 1024}; pg8::SampleOrder S; S.init(MP, NIN, 1024, (int)blockIdx.x); \
            pg8::EpiMix E{p.Q, p.K, p.V, p.G, p.U, p.ropeC, p.ropeS}; \
            pg8::gemm_phase<pg8::EpiMix, pg8::SampleOrder, true, true>(lds, g, S, E); \
        } \
        if ((int)blockIdx.x >= nb0) { \
            const int nbk = G - nb0, bi = (int)blockIdx.x - nb0, per = 1024 / nbk, ext = 1024 % nbk; \
            const int i0 = bi * per + (bi < ext ? bi : ext), i1 = i0 + per + (bi < ext ? 1 : 0);     \
            la_items(p, lds, (i0 + 1) >> 1, (i1 + 1) >> 1, tid);            \
            conv_items(p, lds, i0 >> 1, i1 >> 1, tid);                       \
        } \
    } while (0)
#define PH_8 do { \
        scan_phase(p, tid, G); xcd_barrier(bar); \
        for (int rep_ = 0; rep_ < args.rep[0]; ++rep_) for (int it = blockIdx.x; it < 512; it += G) { \
            const int id2 = it & 255, bh = id2 >> 3, c = it < 256 ? (id2 & 7) : 15 - (id2 & 7); \
            retb_item(p, lds, bh >> 2, bh & 3, c, tid); \
        } \
        for (int rep_ = 0; rep_ < args.rep[1]; ++rep_) for (int it = blockIdx.x; it < 512; it += G) sret_item(p, lds, it >> 2, it & 3, tid); \
        for (int rep_ = 0; rep_ < args.rep[2]; ++rep_) for (int it = blockIdx.x; it < 128; it += G) conv_item<true>(p, lds, it, 0, 4, tid); \
    } while (0)
#define PH_9 do { \
        pg8::Gemm g{p.H, p.Woutt, M, 1024, 1024}; pg8::ResidOrder S; S.init(MP, 1024, 1024, G, (int)blockIdx.x, 8); \
        pg8::EpiResid<false> E{nullptr, p.XB, p.XB, p.PART, p.ada + 5 * 1024, 1.0f}; \
        pg8::gemm_phase<pg8::EpiResid<false>, pg8::ResidOrder, true, true>(lds, g, S, E); \
    } while (0)
#define PH_10 do { norm_mod_phase(nullptr, p.XB, X + (size_t)MP * D, X + (size_t)MP * D, p.PART, 8, p.norm2, p.ada, 6, 7, p.H, tid, G); } while (0)
#define PH_11 do { \
        pg8::Gemm g{p.H, p.W5t, M, 2 * FF, 1024}; pg8::StaticOrder S; S.init(M, 2 * FF, 1024, G, (int)blockIdx.x); \
        pg8::EpiSwiGLU E{p.ACT}; \
        pg8::gemm_phase<pg8::EpiSwiGLU, pg8::StaticOrder, true, true>(lds, g, S, E); \
    } while (0)
#define PH_12 do { \
        pg8::Gemm g{p.ACT, p.Wd2t, M, 1024, FF}; pg8::ResidOrder S; S.init(MP, 1024, FF, G, (int)blockIdx.x, 11); \
        pg8::EpiResid<false> E{nullptr, p.XB, p.XB, p.PART, p.ada + 8 * 1024, 0.5f}; \
        pg8::gemm_phase<pg8::EpiResid<false>, pg8::ResidOrder, true, true>(lds, g, S, E); \
    } while (0)
#define PH_13 do { final_norm_phase(X, p.XB, p.PART, 11, p.normf, tid, G); } while (0)

#ifdef SYNCPROBE
    for (int i_ = 0; i_ < SYNCPROBE; ++i_) xcd_barrier(bar);
#endif
    if (IN(0)) { PH_0; if ((REPMASK >> 0) & 1) { xcd_barrier(bar); PH_0; } } SEAM(0);
    if (IN(1)) { PH_1; if ((REPMASK >> 1) & 1) { xcd_barrier(bar); PH_1; } } SEAM(1);
    if (IN(2)) { PH_2; if ((REPMASK >> 2) & 1) { xcd_barrier(bar); PH_2; } } SEAM(2);
    if (IN(3)) { PH_3; if ((REPMASK >> 3) & 1) { xcd_barrier(bar); PH_3; } } SEAM(3);
    if (IN(4)) { PH_4; if ((REPMASK >> 4) & 1) { xcd_barrier(bar); PH_4; } } SEAM(4);
    if (IN(5)) { PH_5; if ((REPMASK >> 5) & 1) { xcd_barrier(bar); PH_5; } } SEAM(5);
    if (IN(6)) { PH_6; if ((REPMASK >> 6) & 1) { xcd_barrier(bar); PH_6; } } SEAM(6);
    if (IN(7)) { PH_7; if ((REPMASK >> 7) & 1) { xcd_barrier(bar); PH_7; } } SEAM(7);
    if (IN(8)) { PH_8; if ((REPMASK >> 8) & 1) { xcd_barrier(bar); PH_8; } } SEAM(8);
    if (IN(9)) { PH_9; if ((REPMASK >> 9) & 1) { xcd_barrier(bar); PH_9; } } SEAM(9);
    if (IN(10)) { PH_10; if ((REPMASK >> 10) & 1) { xcd_barrier(bar); PH_10; } } SEAM(10);
    if (IN(11)) { PH_11; if ((REPMASK >> 11) & 1) { xcd_barrier(bar); PH_11; } } SEAM(11);
    if (IN(12)) { PH_12; if ((REPMASK >> 12) & 1) { xcd_barrier(bar); PH_12; } } SEAM(12);
    if (IN(13)) { PH_13; if ((REPMASK >> 13) & 1) { xcd_barrier(bar); PH_13; } }
#undef IN
#undef SEAM
}

extern "C" void kernel_launch(void* const* d_in, const int* in_sizes, int n_in, void* d_out, int out_size, void* d_ws, size_t ws_size, hipStream_t stream) {
    static int grid = 0;
    if (grid == 0) {
        if (n_in != 25 || ws_size < WS_END) { fprintf(stderr, "kernel_launch: unexpected n_in %d / ws_size %zu\n", n_in, ws_size); grid = -1; return; }
        int dev = 0, cus = 0, per_cu = 0;
        if (hipGetDevice(&dev) != hipSuccess || hipDeviceGetAttribute(&cus, hipDeviceAttributeMultiprocessorCount, dev) != hipSuccess) { grid = -1; return; }
        if (hipFuncSetAttribute((const void*)fwd_kernel, hipFuncAttributeMaxDynamicSharedMemorySize, LDS_BYTES) != hipSuccess) { fprintf(stderr, "kernel_launch: hipFuncSetAttribute failed\n"); grid = -1; return; }
        if (hipOccupancyMaxActiveBlocksPerMultiprocessor(&per_cu, (const void*)fwd_kernel, 512, LDS_BYTES) != hipSuccess || per_cu < 1) { fprintf(stderr, "kernel_launch: occupancy query says %d\n", per_cu); per_cu = 1; }
        (void)hipGetLastError();
        grid = cus;
    }
    if (grid < 0) return;
    if (hipMemsetAsync(d_ws, 0, 20480, stream) != hipSuccess) { fprintf(stderr, "kernel_launch: memset failed\n"); return; }
    Args a{};
    for (int i = 0; i < 25; ++i) a.in[i] = (const float*)d_in[i];
    a.out = (float*)d_out; a.ws = (unsigned char*)d_ws;
    a.rep[0] = PROBE_R0; a.rep[1] = PROBE_R1; a.rep[2] = PROBE_R2; a.rep[3] = 1;
#if MK_N_LAUNCHES == 1
    a.ph_lo = 0; a.ph_hi = NPHASE;
    void* kargs[] = {&a};
    hipError_t e = hipLaunchCooperativeKernel((const void*)fwd_kernel, dim3(grid), dim3(512), kargs, LDS_BYTES, stream);
    if (e != hipSuccess) fprintf(stderr, "kernel_launch: cooperative launch failed: %s (grid %d)\n", hipGetErrorString(e), grid);
#else
    for (int ph = 0; ph < NPHASE; ++ph) { a.ph_lo = ph; a.ph_hi = ph + 1; hipLaunchKernelGGL(fwd_kernel, dim3(grid), dim3(512), LDS_BYTES, stream, a); }
#endif
}
```

```cpp
#include <hip/hip_runtime.h>
#include <hip/hip_cooperative_groups.h>
#include <cstdio>
#include <cstdint>
namespace cg = cooperative_groups;
namespace pg8 {
#define PG8_LAS __attribute__((address_space(3)))
typedef unsigned short bf16_t;
typedef short bf16x8 __attribute__((ext_vector_type(8)));
typedef float f32x4 __attribute__((ext_vector_type(4)));
typedef unsigned u32x4 __attribute__((ext_vector_type(4)));
constexpr int BM = 256, BK = 64, HALF = 128, HTB = HALF * BK * 2  , STAGE_BYTES = 8 * HTB, NXCD = 8, WGM = 4;

__host__ __device__ __forceinline__ int lds_byte(int r, int c) { const int st = (r >> 4) * 2 + (c >> 5), rr = r & 15, cc = c & 31, ob = rr * 64 + cc * 2; return st * 1024 + (ob ^ (((ob >> 9) & 1) << 5)); }
__host__ __device__ __forceinline__ void stage_rc(int b, int& R, int& C) { const int st = b / 1024, sb = b % 1024, swz = sb ^ (((sb >> 9) & 1) << 5); R = (st >> 1) * 16 + swz / 64; C = (st & 1) * 32 + (swz % 64) / 2; }
__host__ __device__ __forceinline__ int perm32(int rho) { const int n = rho >> 4, i = rho & 15; return 8 * (i >> 2) + 4 * n + (i & 3); }

struct Unit { int pm, pn, k0, nt, si; };
struct Gemm { const bf16_t* A; const bf16_t* Bt; int M, N, K; };

struct StaticOrder {
    int nM, nN, nwg, G, c, ntk;
    __host__ __device__ void init(int M, int N, int K, int G_, int c_) { nM = M / BM; nN = N / BM; nwg = nM * nN; G = G_; c = c_; ntk = K / BK; }
    __host__ __device__ bool next(int i, Unit& u) const {
        const long L = (long)i * G + c; if (L >= nwg) return false;
        int wgid = (int)L; { const int q = nwg / NXCD, r = nwg % NXCD, xcd = wgid % NXCD, off = wgid / NXCD; wgid = (xcd < r ? xcd * (q + 1) : r * (q + 1) + (xcd - r) * q) + off; }
        const int nig = WGM * nN, gid = wgid / nig, fm = gid * WGM, gsz = (nM - fm) < WGM ? (nM - fm) : WGM;
        u.pm = fm + ((wgid % nig) % gsz); u.pn = (wgid % nig) / gsz; u.k0 = 0; u.nt = ntk; u.si = 0; return true;
    }
    __device__ __forceinline__ void a_ready(const Unit&) const {}
    __device__ __forceinline__ void done(const Unit&) const {}
};
struct ResidOrder {
    StaticOrder so; int ks, npairs;
    __host__ __device__ void init(int MPr, int N, int K, int G_, int c_, int ks_) { so.init(MPr, N, K, G_, c_); ks = ks_; npairs = K / (2 * BK); }
    __host__ __device__ bool next(int i, Unit& u) const {
        long L;
        if (so.G == so.nwg && so.c < 8 * ks) { if (i == 1) return so.next(0, u); if (i != 0) return false; L = so.c; }
        else { if (so.next(i, u)) return true; L = (long)i * so.G + so.c - so.nwg; if (L < 0 || L >= 8 * ks) return false; }
        const int j = (int)L, t = j / ks, s = j % ks, base = npairs / ks, rem = npairs % ks;
        u.pm = so.nM + (t >> 2); u.pn = t & 3; u.k0 = (s * base + (s < rem ? s : rem)) * 2 * BK; u.nt = 2 * (base + (s < rem ? 1 : 0)); u.si = s; return true;
    }
    __device__ __forceinline__ void a_ready(const Unit&) const {}
    __device__ __forceinline__ void done(const Unit&) const {}
};
struct SampleOrder {
    int nM0, nN, c, ntk;
    __host__ __device__ void init(int MPr, int N, int K, int c_) { nM0 = MPr / BM; nN = N / BM; c = c_; ntk = K / BK; }
    __host__ __device__ bool next(int i, Unit& u) const { if (i > 0 || c >= 2 * nN) return false; u.pm = nM0 + c / nN; u.pn = c % nN; u.k0 = 0; u.nt = ntk; u.si = 0; return true; }
    __device__ __forceinline__ void a_ready(const Unit&) const {}
    __device__ __forceinline__ void done(const Unit&) const {}
};
__device__ __forceinline__ unsigned cvt_pk_bf16(float lo, float hi) { unsigned r; asm volatile("v_cvt_pk_bf16_f32 %0, %1, %2" : "=v"(r) : "v"(lo), "v"(hi)); return r; }
typedef float f32x2 __attribute__((ext_vector_type(2)));
template <class Epi, class Sched, bool ALIGN_EPI = false, bool SP2 = false>
__device__ __forceinline__ void gemm_phase(PG8_LAS unsigned char* lds, const Gemm g, const Sched& S, const Epi& E) {
    const int tid = threadIdx.x, wid = __builtin_amdgcn_readfirstlane(tid >> 6), lane = tid & 63, wr = wid >> 2, wc = wid & 3, fr = lane & 15, fq = lane >> 4;
    const int K = g.K;
    unsigned voffA[2], voffB[2];
#pragma unroll
    for (int i = 0; i < 2; ++i) { int R, C; stage_rc(tid * 16 + i * 8192, R, C); const int Rb = Epi::PERM ? ((R & ~31) + perm32(R & 31)) : R;
        voffA[i] = (unsigned)(R * K + C) * 2u; voffB[i] = (unsigned)(Rb * K + C) * 2u; }
    const size_t kstep = (size_t)(BK * 2);
    const size_t hstep = (size_t)HALF * K * 2;
    const size_t tstep = 2 * hstep;
    const unsigned ldsw = (unsigned)wid * 1024u;
    const int aoff = lds_byte(wr * 64 + fr, fq * 8), boff = lds_byte(wc * 32 + fr, fq * 8);
#define PG8_SA(b, h) (((b) * 2 + (h)) * HTB)
#define PG8_SB(b, h) ((4 + (b) * 2 + (h)) * HTB)
#define PG8_STAGE(bufoff, gbase, voff) do { _Pragma("unroll") for (int _i = 0; _i < 2; ++_i) \
        __builtin_amdgcn_global_load_lds((const unsigned*)((const char*)(gbase) + (voff)[_i]), (PG8_LAS unsigned*)(lds + (bufoff) + ldsw + _i * 8192), 16, 0, 0); } while (0)
#define PG8_LDA(dst, b, h) do { _Pragma("unroll") for (int m = 0; m < 4; ++m) _Pragma("unroll") for (int k = 0; k < 2; ++k) dst[m][k] = *(const PG8_LAS bf16x8*)(lds + PG8_SA(b, h) + aoff + m * 2048 + k * 1024); } while (0)
#define PG8_LDB(dst, b, h) do { _Pragma("unroll") for (int n = 0; n < 2; ++n) _Pragma("unroll") for (int k = 0; k < 2; ++k) dst[n][k] = *(const PG8_LAS bf16x8*)(lds + PG8_SB(b, h) + boff + n * 2048 + k * 1024); } while (0)
#define PG8_MMA(ai, bj, At, Bt) do { __builtin_amdgcn_s_setprio(1); _Pragma("unroll") for (int m = 0; m < 4; ++m) _Pragma("unroll") for (int n = 0; n < 2; ++n) _Pragma("unroll") for (int k = 0; k < 2; ++k) \
        acc[ai][bj][m][n] = __builtin_amdgcn_mfma_f32_16x16x32_bf16(Bt[n][k], At[m][k], acc[ai][bj][m][n], 0, 0, 0); __builtin_amdgcn_s_setprio(0); } while (0)
#define PG8_WAIT_V(n) asm volatile("s_waitcnt vmcnt(" #n ")" ::: "memory")
#define PG8_WAIT_L(n) asm volatile("s_waitcnt lgkmcnt(" #n ")" ::: "memory")
#define PG8_BAR __builtin_amdgcn_s_barrier()
#define PG8_SCHED __builtin_amdgcn_sched_barrier(0)
    Unit cur, nxt; int ui = 0;
    if (!S.next(0, cur)) return;
    f32x4 acc[2][2][4][2];
#pragma unroll
    for (int a = 0; a < 2; ++a)
#pragma unroll
        for (int b = 0; b < 2; ++b)
#pragma unroll
            for (int m = 0; m < 4; ++m)
#pragma unroll
                for (int n = 0; n < 2; ++n) acc[a][b][m][n] = (f32x4){0.f, 0.f, 0.f, 0.f};
    bf16x8 At[4][2], B0[2][2], B1[2][2];
    const char* cA = (const char*)g.A + (size_t)cur.pm * tstep + (size_t)cur.k0 * 2; const char* cB = (const char*)g.Bt + (size_t)cur.pn * tstep + (size_t)cur.k0 * 2;
    S.a_ready(cur);
    if constexpr (SP2) {
        PG8_STAGE(PG8_SB(0, 0), cB, voffB); PG8_STAGE(PG8_SB(0, 1), cB + hstep, voffB); PG8_STAGE(PG8_SA(0, 0), cA, voffA); PG8_STAGE(PG8_SA(0, 1), cA + hstep, voffA);
        if (wr == 1) PG8_BAR;
        PG8_WAIT_V(2); PG8_BAR;
        PG8_STAGE(PG8_SB(1, 0), cB + kstep, voffB); PG8_STAGE(PG8_SA(1, 0), cA + kstep, voffA); PG8_STAGE(PG8_SB(1, 1), cB + hstep + kstep, voffB);
        PG8_WAIT_V(6); PG8_BAR;
    } else {
        PG8_STAGE(PG8_SB(0, 0), cB, voffB); PG8_STAGE(PG8_SA(0, 0), cA, voffA); PG8_STAGE(PG8_SB(0, 1), cB + hstep, voffB); PG8_STAGE(PG8_SA(0, 1), cA + hstep, voffA);
        if (wr == 1) PG8_BAR;
        PG8_WAIT_V(4); PG8_BAR;
        PG8_STAGE(PG8_SB(1, 0), cB + kstep, voffB); PG8_STAGE(PG8_SA(1, 0), cA + kstep, voffA); PG8_STAGE(PG8_SB(1, 1), cB + hstep + kstep, voffB);
        PG8_WAIT_V(6); PG8_BAR;
    }
    for (;;) {
        const bool has_next = S.next(ui + 1, nxt);
        const char* nA = has_next ? (const char*)g.A + (size_t)nxt.pm * tstep + (size_t)nxt.k0 * 2 : cA; const char* nB = has_next ? (const char*)g.Bt + (size_t)nxt.pn * tstep + (size_t)nxt.k0 * 2 : cB;
        const int nt = cur.nt;
        for (int t = 0; t < nt; t += 2) {
            const bool last = (t == nt - 2);
            const char* a1 = cA + (size_t)(t + 1) * kstep;
            const char* a2 = last ? nA : cA + (size_t)(t + 2) * kstep; const char* b2 = last ? nB : cB + (size_t)(t + 2) * kstep;
            const char* a3 = a2 + kstep; const char* b3 = b2 + kstep;
            if (last && has_next) S.a_ready(nxt);
            if constexpr (SP2) {
            PG8_LDB(B0, 0, 0); PG8_LDB(B1, 0, 1); PG8_SCHED; PG8_LDA(At, 0, 0); PG8_STAGE(PG8_SA(1, 1), a1 + hstep, voffA);
            PG8_WAIT_V(8); PG8_WAIT_L(0); PG8_BAR; PG8_MMA(0, 0, At, B0); PG8_MMA(0, 1, At, B1); PG8_BAR; PG8_SCHED;
            PG8_LDA(At, 0, 1); PG8_STAGE(PG8_SB(0, 0), b2, voffB); PG8_STAGE(PG8_SB(0, 1), b2 + hstep, voffB); PG8_STAGE(PG8_SA(0, 0), a2, voffA);
            PG8_WAIT_V(8); PG8_WAIT_L(0); PG8_BAR; PG8_MMA(1, 0, At, B0); PG8_MMA(1, 1, At, B1); PG8_BAR; PG8_SCHED;
            PG8_LDB(B0, 1, 0); PG8_LDB(B1, 1, 1); PG8_SCHED; PG8_LDA(At, 1, 0); PG8_STAGE(PG8_SA(0, 1), a2 + hstep, voffA);
            PG8_WAIT_V(8); PG8_WAIT_L(0); PG8_BAR; PG8_MMA(0, 0, At, B0); PG8_MMA(0, 1, At, B1); PG8_BAR; PG8_SCHED;
            PG8_LDA(At, 1, 1); PG8_STAGE(PG8_SB(1, 0), b3, voffB); PG8_STAGE(PG8_SB(1, 1), b3 + hstep, voffB); PG8_STAGE(PG8_SA(1, 0), a3, voffA);
            PG8_WAIT_V(8); PG8_WAIT_L(0); PG8_BAR; PG8_MMA(1, 0, At, B0); PG8_MMA(1, 1, At, B1); PG8_BAR; PG8_SCHED;
            } else {
            PG8_LDB(B0, 0, 0); PG8_SCHED; PG8_LDA(At, 0, 0); PG8_STAGE(PG8_SA(1, 1), a1 + hstep, voffA);
            PG8_WAIT_L(8); PG8_BAR; PG8_WAIT_L(0); PG8_MMA(0, 0, At, B0); PG8_BAR; PG8_SCHED;
            PG8_LDB(B1, 0, 1); PG8_STAGE(PG8_SB(0, 0), b2, voffB);
            PG8_BAR; PG8_WAIT_L(0); PG8_MMA(0, 1, At, B1); PG8_BAR;
            PG8_LDA(At, 0, 1); PG8_STAGE(PG8_SA(0, 0), a2, voffA);
            PG8_BAR; PG8_WAIT_L(0); PG8_MMA(1, 0, At, B0); PG8_BAR; PG8_SCHED;
            PG8_STAGE(PG8_SB(0, 1), b2 + hstep, voffB);
            PG8_WAIT_V(6); PG8_BAR; PG8_MMA(1, 1, At, B1); PG8_BAR;
            PG8_LDB(B0, 1, 0); PG8_SCHED; PG8_LDA(At, 1, 0); PG8_STAGE(PG8_SA(0, 1), a2 + hstep, voffA);
            PG8_WAIT_L(8); PG8_BAR; PG8_WAIT_L(0); PG8_MMA(0, 0, At, B0); PG8_BAR; PG8_SCHED;
            PG8_LDB(B1, 1, 1); PG8_STAGE(PG8_SB(1, 0), b3, voffB);
            PG8_BAR; PG8_WAIT_L(0); PG8_MMA(0, 1, At, B1); PG8_BAR;
            PG8_LDA(At, 1, 1); PG8_STAGE(PG8_SA(1, 0), a3, voffA);
            PG8_BAR; PG8_WAIT_L(0); PG8_MMA(1, 0, At, B0); PG8_BAR; PG8_SCHED;
            PG8_STAGE(PG8_SB(1, 1), b3 + hstep, voffB);
            PG8_WAIT_V(6); PG8_BAR; PG8_MMA(1, 1, At, B1); PG8_BAR;
            }
        }
        if constexpr (ALIGN_EPI) { if (wr == 0) PG8_BAR; }
        if constexpr (!Epi::AFTER_DRAIN) { E(acc, cur, wr, wc, fr, fq); S.done(cur); }
        if (!has_next) break;
#pragma unroll
        for (int a = 0; a < 2; ++a)
#pragma unroll
            for (int b = 0; b < 2; ++b)
#pragma unroll
                for (int m = 0; m < 4; ++m)
#pragma unroll
                    for (int n = 0; n < 2; ++n) acc[a][b][m][n] = (f32x4){0.f, 0.f, 0.f, 0.f};
        cur = nxt; cA = nA; cB = nB; ++ui;
        if constexpr (ALIGN_EPI) { if (wr == 1) PG8_BAR; }
    }
    PG8_WAIT_V(0);
    if constexpr (!ALIGN_EPI) { if (wr == 0) PG8_BAR; }
    PG8_BAR;
    if constexpr (Epi::AFTER_DRAIN) { E.fused(acc, cur, wr, wc, fr, fq, lds, wid, lane); S.done(cur); }
#undef PG8_SA
#undef PG8_SB
#undef PG8_STAGE
#undef PG8_LDA
#undef PG8_LDB
#undef PG8_MMA
#undef PG8_WAIT_V
#undef PG8_WAIT_L
#undef PG8_BAR
#undef PG8_SCHED
}
}

#ifndef PROBE_R0
#define PROBE_R0 1
#define PROBE_R1 1
#define PROBE_R2 1
#endif
#ifndef REPMASK
#define REPMASK 0
#endif
#ifndef MK_N_LAUNCHES
#define MK_N_LAUNCHES 1
#endif
constexpr int D = 1024, FF = 2816, MP = 16384, MS = 512, M = MP + MS, NIN = 3072, HW = 512;
constexpr int ADA_LD = 9216;
constexpr float EPS = 1e-6f;
constexpr float LOG2E = 1.4426950408889634f;
constexpr int NPHASE = 14;
constexpr size_t O_Y = 0, O_RSP = 17301504, O_CSP = 17825792, O_RSS = 17948672, O_CSS = 26337280;
constexpr size_t MiB = 1u << 20;
constexpr size_t WS_W1 = 1 * MiB, WS_WD1 = 12 * MiB, WS_WADA = 18 * MiB, WS_WIN = 36 * MiB, WS_WOUT = 42 * MiB, WS_W5 = 44 * MiB, WS_WD2 = 55 * MiB;
constexpr size_t WS_ADA = 61 * MiB, WS_SC = 70 * MiB, WS_ROPE = 71 * MiB, WS_H = 73 * MiB, WS_ACT = 106 * MiB, WS_L = 1 * MiB, WS_XB = 197 * MiB, WS_PART = 230 * MiB, WS_END = 252 * MiB;
constexpr size_t QKV_BYTES = (size_t)M * HW * 2;
constexpr int ROPE_N = 2052 * 64;
constexpr int LDS_BYTES = 147456, RING_BYTES = 131072;

#define LAS __attribute__((address_space(3)))
typedef unsigned short bf16_t;
typedef float f32x4 __attribute__((ext_vector_type(4)));
typedef float f32x2 __attribute__((ext_vector_type(2)));
typedef unsigned u32x4 __attribute__((ext_vector_type(4)));
typedef unsigned u32x2 __attribute__((ext_vector_type(2)));
typedef short bf16x8 __attribute__((ext_vector_type(8)));
using pg8::cvt_pk_bf16;

__device__ __forceinline__ float bf2f(unsigned v) { return __uint_as_float(v << 16); }
__device__ __forceinline__ float bflo(unsigned w) { return __uint_as_float(w << 16); }
__device__ __forceinline__ float bfhi(unsigned w) { return __uint_as_float(w & 0xffff0000u); }
__device__ __forceinline__ float sigm(float x) { return __builtin_amdgcn_rcpf(1.0f + __builtin_amdgcn_exp2f(-x * LOG2E)); }
__device__ __forceinline__ float silu(float x) { return x * sigm(x); }
__device__ __forceinline__ float wave_sum(float v) {
#pragma unroll
    for (int o = 1; o < 64; o <<= 1) v += __shfl_xor(v, o);
    return v;
}
__device__ __forceinline__ int ada_row(int r) { return r < MP ? (r >> 11) : 8 + ((r - MP) >> 2); }
__device__ __forceinline__ float lg2gamma(int h) { return h == 0 ? -0.04580368961312479f : h == 1 ? -0.02272007650008353f : h == 2 ? -0.011315313227834146f : -0.005646563141142063f; }

struct P {
    const float *xp, *xs, *cp, *cs, *state_ret, *state_conv, *norm1, *wg1, *wu1, *wd1, *normmix, *win, *gngain, *dww, *dwb, *lng, *lnb, *wout, *norm2, *wg2, *wu2, *wd2, *wada, *bada, *normf;
    float* out; unsigned char* ws;
    bf16_t *W1t, *Wd1t, *Wint, *Woutt, *W5t, *Wd2t, *Wadat, *SC, *H, *ACT, *Q, *K, *V, *G, *U;
    float *ada, *ropeC, *ropeS, *L, *PART; bf16_t* XB; bf16_t* SP;
};

namespace pg8 {
struct EpiSwiGLU { static constexpr bool PERM = true, AFTER_DRAIN = false;
    bf16_t* O;
    __device__ __forceinline__ void operator()(const f32x4 (&acc)[2][2][4][2], const Unit& u, int wr, int wc, int fr, int fq) const {
        const int row0 = u.pm * BM + wr * 64 + fr, col0 = u.pn * 128 + wc * 32 + 8 * fq;
#pragma unroll
        for (int ai = 0; ai < 2; ++ai)
#pragma unroll
            for (int m = 0; m < 4; ++m) {
                bf16_t* rowp = O + (size_t)(row0 + ai * HALF + m * 16) * FF + col0;
                const f32x4 g0 = acc[ai][0][m][0], g1 = acc[ai][0][m][1], u0 = acc[ai][1][m][0], u1 = acc[ai][1][m][1];
                u32x4 w;
                w.x = cvt_pk_bf16(silu(g0[0]) * u0[0], silu(g0[1]) * u0[1]); w.y = cvt_pk_bf16(silu(g0[2]) * u0[2], silu(g0[3]) * u0[3]);
                w.z = cvt_pk_bf16(silu(g1[0]) * u1[0], silu(g1[1]) * u1[1]); w.w = cvt_pk_bf16(silu(g1[2]) * u1[2], silu(g1[3]) * u1[3]);
                *(u32x4*)rowp = w;
            }
    }
};
template <bool RES_F32>
struct EpiResid { static constexpr bool PERM = true, AFTER_DRAIN = false;
    const float* rf; const bf16_t* rb; bf16_t* out; float* part; const float* gate; float scale;
    __device__ __forceinline__ void operator()(const f32x4 (&acc)[2][2][4][2], const Unit& u, int wr, int wc, int fr, int fq) const {
        const int col0 = u.pn * BM + wc * 32 + 8 * fq;
        if (u.pm < MP / BM) {
            const float* gp = gate + (size_t)(u.pm >> 3) * ADA_LD + col0;
            f32x4 gv[2][2];
#pragma unroll
            for (int bj = 0; bj < 2; ++bj)
#pragma unroll
                for (int n = 0; n < 2; ++n) gv[bj][n] = *(const f32x4*)(gp + bj * HALF + n * 4) * scale;
#pragma unroll
            for (int ai = 0; ai < 2; ++ai)
#pragma unroll
                for (int mp = 0; mp < 2; ++mp) {
                    const size_t off = (size_t)(u.pm * BM + ai * HALF + wr * 64 + mp * 32 + fr) * D + col0;
                    f32x4 rv[2][2][2];
                    if (RES_F32) {
#pragma unroll
                        for (int mm = 0; mm < 2; ++mm)
#pragma unroll
                            for (int bj = 0; bj < 2; ++bj)
#pragma unroll
                                for (int n = 0; n < 2; ++n) rv[mm][bj][n] = *(const f32x4*)(rf + off + (size_t)mm * 16 * D + bj * HALF + n * 4);
                    } else {
#pragma unroll
                        for (int mm = 0; mm < 2; ++mm)
#pragma unroll
                            for (int bj = 0; bj < 2; ++bj) { const u32x4 w = *(const u32x4*)(rb + off + (size_t)mm * 16 * D + bj * HALF);
                                rv[mm][bj][0] = (f32x4){bflo(w.x), bfhi(w.x), bflo(w.y), bfhi(w.y)}; rv[mm][bj][1] = (f32x4){bflo(w.z), bfhi(w.z), bflo(w.w), bfhi(w.w)}; }
                    }
#pragma unroll
                    for (int mm = 0; mm < 2; ++mm)
#pragma unroll
                        for (int bj = 0; bj < 2; ++bj) {
                            const f32x4 o0 = rv[mm][bj][0] + gv[bj][0] * acc[ai][bj][2 * mp + mm][0], o1 = rv[mm][bj][1] + gv[bj][1] * acc[ai][bj][2 * mp + mm][1];
                            u32x4 w; w.x = cvt_pk_bf16(o0[0], o0[1]); w.y = cvt_pk_bf16(o0[2], o0[3]); w.z = cvt_pk_bf16(o1[0], o1[1]); w.w = cvt_pk_bf16(o1[2], o1[3]);
                            *(u32x4*)(out + off + (size_t)mm * 16 * D + bj * HALF) = w;
                        }
                    asm volatile("" ::: "memory");
                }
        } else {
#pragma unroll
            for (int ai = 0; ai < 2; ++ai)
#pragma unroll
                for (int m = 0; m < 4; ++m) {
                    const int r = u.pm * BM + ai * HALF + wr * 64 + m * 16 + fr;
                    const float* gp = gate + (size_t)ada_row(r) * ADA_LD;
                    float* op = part + ((size_t)u.si * MS + (r - MP)) * D;
#pragma unroll
                    for (int bj = 0; bj < 2; ++bj)
#pragma unroll
                        for (int n = 0; n < 2; ++n) { const int col = col0 + bj * HALF + n * 4;
                            const f32x4 gv = *(const f32x4*)(gp + col); *(f32x4*)(op + col) = (gv * scale) * acc[ai][bj][m][n]; }
                }
        }
    }
};
struct EpiAda { static constexpr bool PERM = false, AFTER_DRAIN = false;
    float* out; const float* bias;
    __device__ __forceinline__ void operator()(const f32x4 (&acc)[2][2][4][2], const Unit& u, int wr, int wc, int fr, int fq) const {
        const int col0 = u.pn * BM + wc * 32 + 4 * fq;
#pragma unroll
        for (int ai = 0; ai < 2; ++ai)
#pragma unroll
            for (int m = 0; m < 4; ++m) {
                const int r = u.pm * BM + ai * HALF + wr * 64 + m * 16 + fr;
                float* op = out + (size_t)r * ADA_LD;
#pragma unroll
                for (int bj = 0; bj < 2; ++bj)
#pragma unroll
                    for (int n = 0; n < 2; ++n) { const int col = col0 + bj * HALF + n * 16;
                        *(f32x4*)(op + col) = acc[ai][bj][m][n] + *(const f32x4*)(bias + col); }
            }
    }
};
struct EpiMix { static constexpr bool PERM = true, AFTER_DRAIN = false;
    bf16_t *Q, *Kb, *V, *G, *U; const float* ropeC; const float* ropeS;
    __device__ __forceinline__ void operator()(const f32x4 (&acc)[2][2][4][2], const Unit& u, int wr, int wc, int fr, int fq) const {
        const int pn = u.pn, row0 = u.pm * BM + wr * 64 + fr;
        if (pn < 4) {
            const bool isk = pn >= 2; bf16_t* dstb = isk ? Kb : Q; const float sc = isk ? 0.08838834764831845f : 1.0f;
            const int head = 2 * (pn & 1) + (wc >> 1), d0 = 32 * (wc & 1) + 8 * fq;
#pragma unroll
            for (int ai = 0; ai < 2; ++ai)
#pragma unroll
              for (int mp = 0; mp < 2; ++mp) {
                f32x4 tc[2][2], ts[2][2];
#pragma unroll
                for (int mm = 0; mm < 2; ++mm) { const int r = row0 + ai * HALF + (2 * mp + mm) * 16; const int idx = r < MP ? (r & 2047) : 2048 + ((r - MP) & 3);
                    tc[mm][0] = *(const f32x4*)(ropeC + idx * 64 + d0); tc[mm][1] = *(const f32x4*)(ropeC + idx * 64 + d0 + 4);
                    ts[mm][0] = *(const f32x4*)(ropeS + idx * 64 + d0); ts[mm][1] = *(const f32x4*)(ropeS + idx * 64 + d0 + 4); }
#pragma unroll
                for (int mm = 0; mm < 2; ++mm) {
                    const int m = 2 * mp + mm;
                    const int r = row0 + ai * HALF + m * 16;
                    const f32x4 c0 = tc[mm][0], c1 = tc[mm][1], s0 = ts[mm][0], s1 = ts[mm][1];
                    const f32x4 a0 = acc[ai][0][m][0] * sc, a1 = acc[ai][0][m][1] * sc, b0 = acc[ai][1][m][0] * sc, b1 = acc[ai][1][m][1] * sc;
                    const f32x4 o10 = a0 * c0 - b0 * s0, o11 = a1 * c1 - b1 * s1, o20 = a0 * s0 + b0 * c0, o21 = a1 * s1 + b1 * c1;
                    bf16_t* dst = dstb + (size_t)r * HW + head * 128 + d0;
                    u32x4 w1, w2;
                    w1.x = cvt_pk_bf16(o10[0], o10[1]); w1.y = cvt_pk_bf16(o10[2], o10[3]); w1.z = cvt_pk_bf16(o11[0], o11[1]); w1.w = cvt_pk_bf16(o11[2], o11[3]);
                    w2.x = cvt_pk_bf16(o20[0], o20[1]); w2.y = cvt_pk_bf16(o20[2], o20[3]); w2.z = cvt_pk_bf16(o21[0], o21[1]); w2.w = cvt_pk_bf16(o21[2], o21[3]);
                    *(u32x4*)dst = w1; *(u32x4*)(dst + 64) = w2;
                }
              }
        } else if (pn < 8) {
            const bool isg = pn >= 6; bf16_t* dstb = isg ? G : V; const int colb = 256 * ((pn - 4) & 1) + wc * 32 + 8 * fq;
#pragma unroll
            for (int ai = 0; ai < 2; ++ai)
#pragma unroll
                for (int m = 0; m < 4; ++m) {
                    const int r = row0 + ai * HALF + m * 16;
#pragma unroll
                    for (int bj = 0; bj < 2; ++bj) {
                        f32x4 v0 = acc[ai][bj][m][0], v1 = acc[ai][bj][m][1];
                        if (isg) { v0 = (f32x4){silu(v0[0]), silu(v0[1]), silu(v0[2]), silu(v0[3])}; v1 = (f32x4){silu(v1[0]), silu(v1[1]), silu(v1[2]), silu(v1[3])}; }
                        u32x4 w; w.x = cvt_pk_bf16(v0[0], v0[1]); w.y = cvt_pk_bf16(v0[2], v0[3]); w.z = cvt_pk_bf16(v1[0], v1[1]); w.w = cvt_pk_bf16(v1[2], v1[3]);
                        *(u32x4*)(dstb + (size_t)r * HW + colb + bj * HALF) = w;
                    }
                }
        } else {
            const int colb = 128 * (pn - 8) + wc * 32 + 8 * fq;
#pragma unroll
            for (int ai = 0; ai < 2; ++ai)
#pragma unroll
                for (int m = 0; m < 4; ++m) {
                    const int r = row0 + ai * HALF + m * 16;
                    const f32x4 a0 = acc[ai][0][m][0], a1 = acc[ai][0][m][1], b0 = acc[ai][1][m][0], b1 = acc[ai][1][m][1];
                    u32x4 w;
                    w.x = cvt_pk_bf16(a0[0] * sigm(b0[0]), a0[1] * sigm(b0[1])); w.y = cvt_pk_bf16(a0[2] * sigm(b0[2]), a0[3] * sigm(b0[3]));
                    w.z = cvt_pk_bf16(a1[0] * sigm(b1[0]), a1[1] * sigm(b1[1])); w.w = cvt_pk_bf16(a1[2] * sigm(b1[2]), a1[3] * sigm(b1[3]));
                    *(u32x4*)(U + (size_t)r * HW + colb) = w;
                }
        }
    }
};
}

__device__ __forceinline__ int drow_gate(int n0) { return (n0 >> 7) * 256 + (n0 & 127); }
__device__ __forceinline__ int drow_win(int n0) {
    if (n0 < 1024) { const int sec = n0 >> 9, c = n0 & 511, head = c >> 7, d0 = c & 127, bj = d0 >> 6, d = d0 & 63; return sec * 512 + (head >> 1) * 256 + bj * 128 + (head & 1) * 64 + d; }
    if (n0 < 2048) return n0;
    const int c = n0 - 2048, bj = c >> 9, cc = c & 511; return 2048 + (cc >> 7) * 256 + bj * 128 + (cc & 127);
}
struct TrD { const float* src; bf16_t* dst; int N, K; };
__device__ __forceinline__ TrD tr_mk(const float* W, int K, int N, bf16_t* WT, int kind, int it) {
    const int nblk = N / 32, kb = it / nblk, n0 = 32 * (it % nblk);
    int dr = n0;
    if (kind == 1) dr = drow_gate(n0); else if (kind == 2) dr = drow_gate(n0) + 128; else if (kind == 3) dr = drow_win(n0);
    TrD d; d.src = W + (size_t)(64 * kb) * N + n0; d.dst = WT + (size_t)dr * K + 64 * kb; d.N = N; d.K = K; return d;
}
constexpr int I_GU = 16 * 88, I_DN = 44 * 32, I_IN = 16 * 96, I_OUT = 16 * 32, I_ADA = 16 * 288;
constexpr int TR_REST = 4 * I_GU + 2 * I_DN + I_IN + I_OUT;
__device__ __forceinline__ TrD tr_desc(const P& p, int part, int it) {
    if (part == 0) return tr_mk(p.wada, 1024, 9216, p.Wadat, 0, it);
    int r = it;
    if (r < I_GU) return tr_mk(p.wg1, 1024, FF, p.W1t, 1, r); r -= I_GU;
    if (r < I_GU) return tr_mk(p.wu1, 1024, FF, p.W1t, 2, r); r -= I_GU;
    if (r < I_DN) return tr_mk(p.wd1, FF, 1024, p.Wd1t, 0, r); r -= I_DN;
    if (r < I_IN) return tr_mk(p.win, 1024, NIN, p.Wint, 3, r); r -= I_IN;
    if (r < I_OUT) return tr_mk(p.wout, 1024, 1024, p.Woutt, 0, r); r -= I_OUT;
    if (r < I_GU) return tr_mk(p.wg2, 1024, FF, p.W5t, 1, r); r -= I_GU;
    if (r < I_GU) return tr_mk(p.wu2, 1024, FF, p.W5t, 2, r); r -= I_GU;
    return tr_mk(p.wd2, FF, 1024, p.Wd2t, 0, r);
}
__device__ __forceinline__ void tr_load(const TrD& d, f32x4 (&v)[8], int lane) {
#pragma unroll
    for (int i = 0; i < 8; ++i) v[i] = *(const f32x4*)(d.src + (size_t)((lane >> 3) + 8 * i) * d.N + 4 * (lane & 7));
}
__device__ __forceinline__ void tr_store(const TrD& d, const f32x4 (&v)[8], LAS float* scr, int lane) {
#pragma unroll
    for (int i = 0; i < 8; ++i) { LAS float* q = scr + ((lane >> 3) + 8 * i) * 33 + 4 * (lane & 7); q[0] = v[i][0]; q[1] = v[i][1]; q[2] = v[i][2]; q[3] = v[i][3]; }
    asm volatile("s_waitcnt lgkmcnt(0)" ::: "memory");
    const int c = lane & 7;
#pragma unroll
    for (int j = 0; j < 4; ++j) { const int n = (lane >> 3) + 8 * j; const LAS float* s = scr + (8 * c) * 33 + n;
        u32x4 o; o.x = cvt_pk_bf16(s[0 * 33], s[1 * 33]); o.y = cvt_pk_bf16(s[2 * 33], s[3 * 33]); o.z = cvt_pk_bf16(s[4 * 33], s[5 * 33]); o.w = cvt_pk_bf16(s[6 * 33], s[7 * 33]);
        *(u32x4*)(d.dst + (size_t)n * d.K + 8 * c) = o; }
    asm volatile("s_waitcnt lgkmcnt(0)" ::: "memory");
}
__device__ __forceinline__ void tr_run(const P& p, int part, int nitems, int gw, int NGW, LAS float* scr, int lane) {
    int it = gw; if (it >= nitems) return;
    TrD d = tr_desc(p, part, it); f32x4 v[8]; tr_load(d, v, lane);
    for (;;) {
        const int itn = it + NGW; const bool more = itn < nitems;
        TrD dn = d; f32x4 vn[8];
        if (more) { dn = tr_desc(p, part, itn); tr_load(dn, vn, lane); }
        tr_store(d, v, scr, lane);
        if (!more) break;
        d = dn; it = itn;
#pragma unroll
        for (int i = 0; i < 8; ++i) v[i] = vn[i];
    }
}
__device__ __forceinline__ void rope_table(const P& p, int gt, int NGT) {
    for (int g = gt; g < ROPE_N; g += NGT) {
        const int pi_ = g >> 6, d = g & 63; const int pos = pi_ < 2048 ? pi_ : 16384 + (pi_ - 2048);
        double inv = 1.0; for (int i = 0; i < d; ++i) inv *= 0.8659643233600653;
        const double ang = (double)pos * inv;
        const double k = __builtin_rint(ang * 0.15915494309189535);
        double x = __builtin_fma(-k, 6.283185307179586, ang); x = __builtin_fma(-k, 2.4492935982947064e-16, x);
        const double x2 = x * x;
        double s = 0.0, c = 0.0;
#pragma unroll
        for (int n = 14; n >= 1; --n) { s = (1.0 - s * x2 * (1.0 / ((2.0 * n) * (2.0 * n + 1.0)))); c = (1.0 - c * x2 * (1.0 / ((2.0 * n - 1.0) * (2.0 * n)))); }
        p.ropeC[g] = (float)c; p.ropeS[g] = (float)(s * x);
    }
}
__device__ __forceinline__ void prologue(const P& p, LAS unsigned char* lds, int tid, int G, int part, int b0) {
    const int lane = tid & 63, wave = tid >> 6;
    LAS float* scr = (LAS float*)(lds + wave * 16384);
    if (part == 1) {
        if ((int)blockIdx.x < b0) return;
        rope_table(p, ((int)blockIdx.x - b0) * 512 + tid, (G - b0) * 512);
        tr_run(p, 1, TR_REST, ((int)blockIdx.x - b0) * 8 + wave, (G - b0) * 8, scr, lane);
        return;
    }
    tr_run(p, 0, I_ADA, blockIdx.x * 8 + wave, G * 8, scr, lane);
    const int gt = blockIdx.x * 512 + tid, NGT = G * 512;
    for (int g = gt; g < 256 * 128; g += NGT) {
        const int row = g >> 7, c8 = (g & 127) * 8;
        u32x4 o = (u32x4){0u, 0u, 0u, 0u};
        if (row < 136) { const float* src = row < 8 ? p.cp + (size_t)row * D + c8 : p.cs + (size_t)(row - 8) * D + c8;
            const f32x4 a = *(const f32x4*)src, b = *(const f32x4*)(src + 4);
            o.x = cvt_pk_bf16(silu(a[0]), silu(a[1])); o.y = cvt_pk_bf16(silu(a[2]), silu(a[3])); o.z = cvt_pk_bf16(silu(b[0]), silu(b[1])); o.w = cvt_pk_bf16(silu(b[2]), silu(b[3])); }
        *(u32x4*)(p.SC + (size_t)row * D + c8) = o;
    }
}

template <bool FINAL>
__device__ __forceinline__ void norm_prompt_chunk_b(const bf16_t* x0, const f32x4 (&A)[4], const f32x4 (&B)[4], bf16_t* h0, float* y0, int lane) {
    u32x4 cur[2], nxt[2];
#pragma unroll
    for (int j = 0; j < 2; ++j) cur[j] = *(const u32x4*)(x0 + 8 * lane + 512 * j);
#pragma unroll 1
    for (int r = 0; r < 8; ++r) {
        if (r < 7) {
#pragma unroll
            for (int j = 0; j < 2; ++j) nxt[j] = *(const u32x4*)(x0 + (size_t)(r + 1) * D + 8 * lane + 512 * j);
        }
        f32x4 v[4]; float ss = 0.f;
#pragma unroll
        for (int j = 0; j < 2; ++j) { v[2 * j] = (f32x4){bflo(cur[j].x), bfhi(cur[j].x), bflo(cur[j].y), bfhi(cur[j].y)}; v[2 * j + 1] = (f32x4){bflo(cur[j].z), bfhi(cur[j].z), bflo(cur[j].w), bfhi(cur[j].w)}; }
#pragma unroll
        for (int j = 0; j < 4; ++j) ss += (v[j][0] * v[j][0] + v[j][1] * v[j][1]) + (v[j][2] * v[j][2] + v[j][3] * v[j][3]);
        const float rstd = 1.0f / sqrtf(wave_sum(ss) * (1.0f / D) + EPS);
#pragma unroll
        for (int j = 0; j < 2; ++j) {
            if (FINAL) { float* yp = y0 + (size_t)r * D + 8 * lane + 512 * j; *(f32x4*)yp = v[2 * j] * rstd * A[2 * j]; *(f32x4*)(yp + 4) = v[2 * j + 1] * rstd * A[2 * j + 1]; }
            else { const f32x4 h0v = v[2 * j] * rstd * A[2 * j] + B[2 * j], h1v = v[2 * j + 1] * rstd * A[2 * j + 1] + B[2 * j + 1];
                   u32x4 o; o.x = cvt_pk_bf16(h0v[0], h0v[1]); o.y = cvt_pk_bf16(h0v[2], h0v[3]); o.z = cvt_pk_bf16(h1v[0], h1v[1]); o.w = cvt_pk_bf16(h1v[2], h1v[3]);
                   *(u32x4*)(h0 + (size_t)r * D + 8 * lane + 512 * j) = o; }
        }
#pragma unroll
        for (int j = 0; j < 2; ++j) cur[j] = nxt[j];
    }
}
template <bool FINAL>
__device__ __forceinline__ void norm_prompt_chunk(const float* x0, const f32x4 (&A)[4], const f32x4 (&B)[4], bf16_t* h0, float* y0, int lane) {
    f32x4 cur[4], nxt[4];
#pragma unroll
    for (int j = 0; j < 4; ++j) cur[j] = ((const f32x4*)x0)[lane + 64 * j];
#pragma unroll 1
    for (int r = 0; r < 8; ++r) {
        if (r < 7) {
#pragma unroll
            for (int j = 0; j < 4; ++j) nxt[j] = ((const f32x4*)(x0 + (size_t)(r + 1) * D))[lane + 64 * j];
        }
        float ss = 0.f;
#pragma unroll
        for (int j = 0; j < 4; ++j) ss += (cur[j][0] * cur[j][0] + cur[j][1] * cur[j][1]) + (cur[j][2] * cur[j][2] + cur[j][3] * cur[j][3]);
        const float rstd = 1.0f / sqrtf(wave_sum(ss) * (1.0f / D) + EPS);
#pragma unroll
        for (int j = 0; j < 4; ++j) {
            if (FINAL) ((f32x4*)(y0 + (size_t)r * D))[lane + 64 * j] = cur[j] * rstd * A[j];
            else { const f32x4 h = cur[j] * rstd * A[j] + B[j]; u32x2 o; o.x = cvt_pk_bf16(h[0], h[1]); o.y = cvt_pk_bf16(h[2], h[3]);
                   *(u32x2*)(h0 + (size_t)r * D + 4 * (lane + 64 * j)) = o; }
        }
#pragma unroll
        for (int j = 0; j < 4; ++j) cur[j] = nxt[j];
    }
}
__device__ __forceinline__ void norm_mod_phase(const float* xp, const bf16_t* xb, const float* xs, float* xs_out, const float* part, int ks, const float* gn, const float* ada, int sh_idx, int sc_idx, bf16_t* H, int tid, int G) {
    const int lane = tid & 63, gw = blockIdx.x * 8 + (tid >> 6), NGW = G * 8;
    f32x4 g4[4];
#pragma unroll
    for (int j = 0; j < 4; ++j) g4[j] = *(const f32x4*)(gn + 4 * (lane + 64 * j));
    if (xp) for (int ch = gw; ch < MP / 8; ch += NGW) {
        const int m0 = ch * 8; const float* ar = ada + (size_t)(m0 >> 11) * ADA_LD;
        f32x4 A[4], B[4];
#pragma unroll
        for (int j = 0; j < 4; ++j) { const int col = 4 * (lane + 64 * j); A[j] = g4[j] * (*(const f32x4*)(ar + sc_idx * 1024 + col) + 1.0f); B[j] = *(const f32x4*)(ar + sh_idx * 1024 + col); }
        norm_prompt_chunk<false>(xp + (size_t)m0 * D, A, B, H + (size_t)m0 * D, nullptr, lane);
    }
    if (xb) for (int ch = gw; ch < MP / 8; ch += NGW) {
        const int m0 = ch * 8; const float* ar = ada + (size_t)(m0 >> 11) * ADA_LD;
        f32x4 A[4], B[4];
#pragma unroll
        for (int j = 0; j < 4; ++j) { const int col = 8 * lane + 512 * (j >> 1) + 4 * (j & 1);
            A[j] = *(const f32x4*)(gn + col) * (*(const f32x4*)(ar + sc_idx * 1024 + col) + 1.0f); B[j] = *(const f32x4*)(ar + sh_idx * 1024 + col); }
        norm_prompt_chunk_b<false>(xb + (size_t)m0 * D, A, B, H + (size_t)m0 * D, nullptr, lane);
    }
    for (int ms = gw; ms < MS; ms += NGW) {
        const float* xr = xs + (size_t)ms * D; const float* ar = ada + (size_t)(8 + (ms >> 2)) * ADA_LD;
        f32x4 v[4]; float ss = 0.f;
#pragma unroll
        for (int j = 0; j < 4; ++j) v[j] = ((const f32x4*)xr)[lane + 64 * j];
        if (ks > 0) {
            for (int s = 0; s < ks; ++s) { const f32x4* pr = (const f32x4*)(part + ((size_t)s * MS + ms) * D);
#pragma unroll
                for (int j = 0; j < 4; ++j) v[j] += pr[lane + 64 * j]; }
#pragma unroll
            for (int j = 0; j < 4; ++j) ((f32x4*)(xs_out + (size_t)ms * D))[lane + 64 * j] = v[j];
        }
#pragma unroll
        for (int j = 0; j < 4; ++j) ss += (v[j][0] * v[j][0] + v[j][1] * v[j][1]) + (v[j][2] * v[j][2] + v[j][3] * v[j][3]);
        const float rstd = 1.0f / sqrtf(wave_sum(ss) * (1.0f / D) + EPS);
#pragma unroll
        for (int j = 0; j < 4; ++j) { const int col = 4 * (lane + 64 * j);
            const f32x4 sc4 = *(const f32x4*)(ar + sc_idx * 1024 + col), sh4 = *(const f32x4*)(ar + sh_idx * 1024 + col);
            const f32x4 h = (v[j] * rstd * g4[j]) * (sc4 + 1.0f) + sh4;
            u32x2 o; o.x = cvt_pk_bf16(h[0], h[1]); o.y = cvt_pk_bf16(h[2], h[3]);
            *(u32x2*)(H + (size_t)(MP + ms) * D + col) = o; }
    }
}
__device__ __forceinline__ void final_norm_phase(float* x, const bf16_t* xb, const float* part, int ks, const float* gn, int tid, int G) {
    const int lane = tid & 63, gw = blockIdx.x * 8 + (tid >> 6), NGW = G * 8;
    f32x4 g4[4];
#pragma unroll
    for (int j = 0; j < 4; ++j) g4[j] = *(const f32x4*)(gn + 4 * (lane + 64 * j));
    { f32x4 A[4];
#pragma unroll
      for (int j = 0; j < 4; ++j) A[j] = *(const f32x4*)(gn + 8 * lane + 512 * (j >> 1) + 4 * (j & 1));
      for (int ch = gw; ch < MP / 8; ch += NGW) norm_prompt_chunk_b<true>(xb + (size_t)ch * 8 * D, A, A, nullptr, x + (size_t)ch * 8 * D, lane); }
    for (int ms = gw; ms < MS; ms += NGW) {
        float* xr = x + (size_t)(MP + ms) * D;
        f32x4 v[4]; float ss = 0.f;
#pragma unroll
        for (int j = 0; j < 4; ++j) v[j] = ((const f32x4*)xr)[lane + 64 * j];
        for (int s = 0; s < ks; ++s) { const f32x4* pr = (const f32x4*)(part + ((size_t)s * MS + ms) * D);
#pragma unroll
            for (int j = 0; j < 4; ++j) v[j] += pr[lane + 64 * j]; }
#pragma unroll
        for (int j = 0; j < 4; ++j) ss += (v[j][0] * v[j][0] + v[j][1] * v[j][1]) + (v[j][2] * v[j][2] + v[j][3] * v[j][3]);
        const float rstd = 1.0f / sqrtf(wave_sum(ss) * (1.0f / D) + EPS);
#pragma unroll
        for (int j = 0; j < 4; ++j) ((f32x4*)xr)[lane + 64 * j] = v[j] * rstd * g4[j];
    }
}

constexpr int VSTR = 132;
constexpr int SSTR = 136;
#define MFMA16(a, b, c) __builtin_amdgcn_mfma_f32_16x16x32_bf16((a), (b), (c), 0, 0, 0)
__device__ __forceinline__ int slot_j(int q, int e) { return 16 * (e >> 2) + 4 * q + (e & 3); }

struct Chunk { u32x4 v[4]; };
__device__ __forceinline__ Chunk chunk_load(const bf16_t* src, int tid) {
    const int j = tid >> 2, part = tid & 3; const bf16_t* s = src + (size_t)j * HW + part * 32; Chunk c;
#pragma unroll
    for (int i = 0; i < 4; ++i) c.v[i] = *(const u32x4*)(s + 8 * i);
    return c;
}
template <int STR>
__device__ __forceinline__ void chunk_store(const Chunk& c, LAS bf16_t* dst, int tid) {
    const int j = tid >> 2, part = tid & 3;
#pragma unroll
    for (int i = 0; i < 4; ++i) { LAS u32x2* d = (LAS u32x2*)(dst + j * STR + part * 32 + 8 * i); d[0] = (u32x2){c.v[i].x, c.v[i].y}; d[1] = (u32x2){c.v[i].z, c.v[i].w}; }
}
__device__ __forceinline__ void stage_chunk(const bf16_t* src, LAS bf16_t* dst, int tid, bool decay, float lg2) {
    const int j = tid >> 2, part = tid & 3;
    const bf16_t* s = src + (size_t)j * HW + part * 32;
    const float dec = decay ? __builtin_amdgcn_exp2f(lg2 * (float)(127 - j)) : 1.0f;
#pragma unroll
    for (int i = 0; i < 4; ++i) {
        u32x4 v = *(const u32x4*)(s + 8 * i);
        if (decay) { v.x = cvt_pk_bf16(bflo(v.x) * dec, bfhi(v.x) * dec); v.y = cvt_pk_bf16(bflo(v.y) * dec, bfhi(v.y) * dec); v.z = cvt_pk_bf16(bflo(v.z) * dec, bfhi(v.z) * dec); v.w = cvt_pk_bf16(bflo(v.w) * dec, bfhi(v.w) * dec); }
        LAS u32x2* d = (LAS u32x2*)(dst + j * VSTR + part * 32 + 8 * i);
        d[0] = (u32x2){v.x, v.y}; d[1] = (u32x2){v.z, v.w};
    }
}
__device__ __forceinline__ bf16x8 gather8(const LAS bf16_t* img, int jbase, int col, int q) {
    bf16x8 f;
#pragma unroll
    for (int e = 0; e < 8; ++e) f[e] = (short)img[(jbase + slot_j(q, e)) * VSTR + col];
    return f;
}

__device__ __forceinline__ void la_item(const P& p, LAS unsigned char* lds, int item, int tid) {
    const int c = item & 15, bh = item >> 4, h = bh & 3, b = bh >> 2;
    const int lane = tid & 63, w = __builtin_amdgcn_readfirstlane(tid >> 6), q = lane >> 4, i16 = lane & 15;
    LAS bf16_t* Ks = (LAS bf16_t*)lds; LAS bf16_t* Vs = Ks + 128 * VSTR;
    const size_t r0 = (size_t)b * 2048 + c * 128;
    stage_chunk(p.K + r0 * HW + h * 128, Ks, tid, true, lg2gamma(h));
    stage_chunk(p.V + r0 * HW + h * 128, Vs, tid, false, 0.f);
    __syncthreads();
    f32x4 acc[8];
#pragma unroll
    for (int n = 0; n < 8; ++n) acc[n] = (f32x4){0.f, 0.f, 0.f, 0.f};
#pragma unroll
    for (int kk = 0; kk < 4; ++kk) {
        const bf16x8 kf = gather8(Ks, 32 * kk, 16 * w + i16, q);
#pragma unroll
        for (int n = 0; n < 8; ++n) { const bf16x8 vf = gather8(Vs, 32 * kk, 16 * n + i16, q); acc[n] = MFMA16(vf, kf, acc[n]); }
    }
    float* Lo = p.L + (size_t)(bh * 16 + c) * 16384 + (16 * w + i16) * 128 + 4 * q;
#pragma unroll
    for (int n = 0; n < 8; ++n) *(f32x4*)(Lo + 16 * n) = acc[n];
    __syncthreads();
}

__device__ __forceinline__ void retb_item(const P& p, LAS unsigned char* lds, int b, int h, int c, int tid) {
    const int lane = tid & 63, w = __builtin_amdgcn_readfirstlane(tid >> 6), q = lane >> 4, i16 = lane & 15;
    LAS bf16_t* Vs = (LAS bf16_t*)lds; LAS bf16_t* St = Vs + 128 * VSTR; LAS bf16_t* Ks = St + 128 * SSTR;
    const int bh = b * 4 + h; const size_t r0 = (size_t)b * 2048 + c * 128;
    const float lg2 = lg2gamma(h), gC = __builtin_amdgcn_exp2f(lg2 * 128.0f);
    const Chunk vch = chunk_load(p.V + r0 * HW + h * 128, tid), kch = chunk_load(p.K + r0 * HW + h * 128, tid);
    const int row = (int)r0 + 16 * w + i16;
    bf16x8 Qf[4];
#pragma unroll
    for (int kd = 0; kd < 4; ++kd) Qf[kd] = *(const bf16x8*)(p.Q + (size_t)row * HW + h * 128 + 32 * kd + 8 * q);
    {
        const int dkg = tid >> 5, dvq = tid & 31;
        u32x2 sv[8];
#pragma unroll
        for (int r = 0; r < 8; ++r) sv[r] = (u32x2){0u, 0u};
        if (c > 0) { const bf16_t* sp = p.SP + ((size_t)bh * 16 + c) * 16384 + dkg * 128 + 4 * dvq;
#pragma unroll
            for (int r = 0; r < 8; ++r) sv[r] = *(const u32x2*)(sp + r * 2048); }
#pragma unroll
        for (int r = 0; r < 8; ++r) { LAS bf16_t* d = St + (4 * dvq) * SSTR + dkg + 16 * r;
            d[0] = (bf16_t)(sv[r].x & 0xffffu); d[SSTR] = (bf16_t)(sv[r].x >> 16); d[2 * SSTR] = (bf16_t)(sv[r].y & 0xffffu); d[3 * SSTR] = (bf16_t)(sv[r].y >> 16); }
    }
    chunk_store<VSTR>(vch, Vs, tid); chunk_store<SSTR>(kch, Ks, tid);
    __syncthreads();
    f32x4 acc[8];
#pragma unroll
    for (int n = 0; n < 8; ++n) acc[n] = (f32x4){0.f, 0.f, 0.f, 0.f};
#pragma unroll
    for (int n = 0; n < 8; ++n)
#pragma unroll
        for (int kd = 0; kd < 4; ++kd) { const bf16x8 sf = *(const LAS bf16x8*)(St + (16 * n + i16) * SSTR + 32 * kd + 8 * q); acc[n] = MFMA16(sf, Qf[kd], acc[n]); }
    const int ti = 16 * w + i16;
    { const float dq = __builtin_amdgcn_exp2f(lg2 * (float)(ti + 1));
#pragma unroll
      for (int n = 0; n < 8; ++n) acc[n] = acc[n] * dq; }
#pragma unroll
    for (int kb = 0; kb < 4; ++kb) {
        if (2 * kb <= w) {
            f32x4 st0 = (f32x4){0.f, 0.f, 0.f, 0.f}, st1 = (f32x4){0.f, 0.f, 0.f, 0.f};
            const LAS bf16_t* kp = Ks + (32 * kb + i16) * SSTR + 8 * q;
#pragma unroll
            for (int kd = 0; kd < 4; ++kd) { const bf16x8 kf = *(const LAS bf16x8*)(kp + 32 * kd); st0 = MFMA16(kf, Qf[kd], st0); }
            if (2 * kb + 1 <= w) {
#pragma unroll
                for (int kd = 0; kd < 4; ++kd) { const bf16x8 kf = *(const LAS bf16x8*)(kp + 16 * SSTR + 32 * kd); st1 = MFMA16(kf, Qf[kd], st1); }
            }
            float pv[8];
#pragma unroll
            for (int e = 0; e < 4; ++e) {
                const int j0 = 32 * kb + 4 * q + e, j1 = j0 + 16;
                const int d0 = ti - j0, d1 = ti - j1;
                pv[e] = d0 >= 0 ? st0[e] * __builtin_amdgcn_exp2f(lg2 * (float)d0) : 0.f;
                pv[4 + e] = d1 >= 0 ? st1[e] * __builtin_amdgcn_exp2f(lg2 * (float)d1) : 0.f;
            }
            u32x4 pw; pw.x = cvt_pk_bf16(pv[0], pv[1]); pw.y = cvt_pk_bf16(pv[2], pv[3]); pw.z = cvt_pk_bf16(pv[4], pv[5]); pw.w = cvt_pk_bf16(pv[6], pv[7]);
            const bf16x8 pf = __builtin_bit_cast(bf16x8, pw);
#pragma unroll
            for (int n = 0; n < 8; ++n) { const bf16x8 vf = gather8(Vs, 32 * kb, 16 * n + i16, q); acc[n] = MFMA16(vf, pf, acc[n]); }
        }
    }
    float s = 0.f;
#pragma unroll
    for (int n = 0; n < 8; ++n) s += (acc[n][0] + acc[n][1]) + (acc[n][2] + acc[n][3]);
    s += __shfl_xor(s, 16); s += __shfl_xor(s, 32);
    const float mean = s * (1.0f / 128.0f);
    float vq = 0.f;
#pragma unroll
    for (int n = 0; n < 8; ++n) { const f32x4 d = acc[n] - mean; vq += (d[0] * d[0] + d[1] * d[1]) + (d[2] * d[2] + d[3] * d[3]); }
    vq += __shfl_xor(vq, 16); vq += __shfl_xor(vq, 32);
    const float rstd = 1.0f / sqrtf(vq * (1.0f / 128.0f) + EPS);
    const bf16_t* gp = p.G + (size_t)row * HW + h * 128 + 4 * q;
    const float* gn = p.gngain + h * 128 + 4 * q;
    bf16_t* op = p.H + (size_t)row * D + h * 128 + 4 * q;
#pragma unroll
    for (int n = 0; n < 8; ++n) {
        const u32x2 gw = *(const u32x2*)(gp + 16 * n); const f32x4 g4 = *(const f32x4*)(gn + 16 * n);
        const f32x4 o = (acc[n] - mean) * rstd * g4;
        u32x2 ow; ow.x = cvt_pk_bf16(o[0] * bflo(gw.x), o[1] * bfhi(gw.x)); ow.y = cvt_pk_bf16(o[2] * bflo(gw.y), o[3] * bfhi(gw.y));
        *(u32x2*)(op + 16 * n) = ow;
    }
    __syncthreads();
}

__device__ __forceinline__ void scan_phase(const P& p, int tid, int G) {
    for (int e = blockIdx.x * 512 + tid; e < 32 * 4096; e += G * 512) {
        const int bh = e >> 12, o = (e & 4095) * 4;
        const float gC = __builtin_amdgcn_exp2f(lg2gamma(bh & 3) * 128.0f);
        const float* Lb = p.L + (size_t)bh * 16 * 16384 + o;
        f32x4 l[16];
#pragma unroll
        for (int c = 0; c < 16; ++c) l[c] = *(const f32x4*)(Lb + (size_t)c * 16384);
        f32x4 S = (f32x4){0.f, 0.f, 0.f, 0.f};
        bf16_t* sp = p.SP + (size_t)bh * 16 * 16384 + o;
#pragma unroll
        for (int c = 0; c < 15; ++c) { S = S * gC + l[c]; u32x2 w; w.x = cvt_pk_bf16(S[0], S[1]); w.y = cvt_pk_bf16(S[2], S[3]); *(u32x2*)(sp + (size_t)(c + 1) * 16384) = w; }
        *(f32x4*)(p.out + O_RSP + (size_t)bh * 16384 + o) = S * gC + l[15];
    }
}

__device__ __forceinline__ void sret_item(const P& p, LAS unsigned char* lds, int b, int h, int tid) {
    const int lane = tid & 63, w = __builtin_amdgcn_readfirstlane(tid >> 6);
    LAS float* qs = (LAS float*)lds; LAS float* ks = qs + 512; LAS float* vs = ks + 512; LAS float* os = vs + 512; LAS float* dots = os + 512; LAS float* red = dots + 64;
    const int r0 = MP + 4 * b; const float lg2 = lg2gamma(h);
    f32x4 s0v[8];
    { const float* S0p = p.state_ret + (size_t)(b * 4 + h) * 16384 + (tid >> 5) * 128 + 4 * (tid & 31);
#pragma unroll
      for (int r = 0; r < 8; ++r) s0v[r] = *(const f32x4*)(S0p + r * 2048); }
    { const int tok = tid >> 7, d = tid & 127; const size_t off = (size_t)(r0 + tok) * HW + h * 128 + d;
      qs[tid] = bf2f(p.Q[off]); ks[tid] = bf2f(p.K[off]); vs[tid] = bf2f(p.V[off]); }
    __syncthreads();
#pragma unroll
    for (int pp = 0; pp < 2; ++pp) { const int pr = 2 * w + pp, i = pr >> 2, j = pr & 3;
        float v = qs[i * 128 + lane] * ks[j * 128 + lane] + qs[i * 128 + lane + 64] * ks[j * 128 + lane + 64];
        v = wave_sum(v); if (lane == 0) dots[pr] = v; }
    const int dkg = tid >> 5, dvq = tid & 31;
    const float g1 = __builtin_amdgcn_exp2f(lg2), g2 = g1 * g1, g3 = g2 * g1, g4 = g2 * g2;
    float* Sn = p.out + O_RSS + (size_t)(b * 4 + h) * 16384 + dkg * 128 + 4 * dvq;
    const f32x4 v0 = *(const LAS f32x4*)(vs + 4 * dvq), v1 = *(const LAS f32x4*)(vs + 128 + 4 * dvq), v2 = *(const LAS f32x4*)(vs + 256 + 4 * dvq), v3 = *(const LAS f32x4*)(vs + 384 + 4 * dvq);
    f32x4 cr0 = (f32x4){0.f, 0.f, 0.f, 0.f}, cr1 = cr0, cr2 = cr0, cr3 = cr0;
#pragma unroll
    for (int r = 0; r < 8; ++r) { const int dk = dkg + 16 * r;
        const f32x4 s0 = s0v[r];
        cr0 += s0 * qs[dk]; cr1 += s0 * qs[128 + dk]; cr2 += s0 * qs[256 + dk]; cr3 += s0 * qs[384 + dk];
        const f32x4 sn = s0 * g4 + v0 * (ks[dk] * g3) + v1 * (ks[128 + dk] * g2) + v2 * (ks[256 + dk] * g1) + v3 * ks[384 + dk];
        *(f32x4*)(Sn + r * 2048) = sn; }
    *(LAS f32x4*)(red + (dkg * 4 + 0) * 128 + 4 * dvq) = cr0; *(LAS f32x4*)(red + (dkg * 4 + 1) * 128 + 4 * dvq) = cr1;
    *(LAS f32x4*)(red + (dkg * 4 + 2) * 128 + 4 * dvq) = cr2; *(LAS f32x4*)(red + (dkg * 4 + 3) * 128 + 4 * dvq) = cr3;
    __syncthreads();
    { const int i = tid >> 7, dv = tid & 127; float cs = 0.f;
#pragma unroll
      for (int g = 0; g < 16; ++g) cs += red[(g * 4 + i) * 128 + dv];
      float o = cs * __builtin_amdgcn_exp2f(lg2 * (float)(i + 1));
#pragma unroll
      for (int j = 0; j < 4; ++j) if (j <= i) o += __builtin_amdgcn_exp2f(lg2 * (float)(i - j)) * dots[i * 4 + j] * vs[j * 128 + dv];
      os[tid] = o; }
    __syncthreads();
    if (w < 4) { const float x0 = os[w * 128 + lane], x1 = os[w * 128 + lane + 64];
        const float mean = wave_sum(x0 + x1) * (1.0f / 128.0f); const float d0 = x0 - mean, d1 = x1 - mean;
        const float rstd = 1.0f / sqrtf(wave_sum(d0 * d0 + d1 * d1) * (1.0f / 128.0f) + EPS);
        const size_t row = (size_t)(r0 + w);
        const float ga = bf2f(p.G[row * HW + h * 128 + lane]), gb = bf2f(p.G[row * HW + h * 128 + lane + 64]);
        const float oa = d0 * rstd * p.gngain[h * 128 + lane] * ga, ob = d1 * rstd * p.gngain[h * 128 + lane + 64] * gb;
        p.H[row * D + h * 128 + lane] = (bf16_t)(cvt_pk_bf16(oa, 0.f) & 0xffffu); p.H[row * D + h * 128 + lane + 64] = (bf16_t)(cvt_pk_bf16(ob, 0.f) & 0xffffu); }
    __syncthreads();
}

template <bool sample>
__device__ __forceinline__ void conv_item(const P& p, LAS unsigned char* lds, int seq, int t0, int ntok, int tid) {
    const int lane = tid & 63, w = __builtin_amdgcn_readfirstlane(tid >> 6);
    LAS bf16_t* us = (LAS bf16_t*)lds;
    LAS float* ys = (LAS float*)(lds + 63488);
    const int rowbase = sample ? MP + 4 * seq : seq * 2048;
    const int nrows = ntok + 30;
    {
        u32x4 sv[8];
#pragma unroll
        for (int i = 0; i < 8; ++i) {
            const int rr = w + 8 * i, tau = t0 - 30 + rr, c8 = lane * 8;
            sv[i] = (u32x4){0u, 0u, 0u, 0u};
            if (rr < nrows) {
                if (tau >= 0) sv[i] = *(const u32x4*)(p.U + (size_t)(rowbase + tau) * HW + c8);
                else if (sample) { const float* s = p.state_conv + ((size_t)seq * 30 + (30 + tau)) * HW + c8; const f32x4 a = *(const f32x4*)s, b = *(const f32x4*)(s + 4);
                    sv[i].x = cvt_pk_bf16(a[0], a[1]); sv[i].y = cvt_pk_bf16(a[2], a[3]); sv[i].z = cvt_pk_bf16(b[0], b[1]); sv[i].w = cvt_pk_bf16(b[2], b[3]); }
            }
        }
#pragma unroll
        for (int i = 0; i < 8; ++i) { const int rr = w + 8 * i; if (rr < nrows) *(LAS u32x4*)(us + rr * 512 + lane * 8) = sv[i]; }
    }
    __syncthreads();
    if (!sample) {
        const int c2 = 2 * (tid & 255), half = tid >> 8;
        f32x2 wk[31];
        { const float* wp = p.dww + c2;
#pragma unroll
          for (int k = 0; k < 31; ++k) { asm volatile("" : "+v"(wp)); wk[k] = *(const f32x2*)wp; wp += HW; } }
        const f32x2 bias = *(const f32x2*)(p.dwb + c2);
        f32x2 ya[16];
#pragma unroll
        for (int t = 0; t < 16; ++t) ya[t] = bias;
        const LAS bf16_t* ub = us + (16 * half) * 512 + c2;
#pragma unroll
        for (int i = 0; i < 46; ++i) {
            const unsigned uw = *(const LAS unsigned*)(ub + i * 512);
            const f32x2 u = (f32x2){bflo(uw), bfhi(uw)};
#pragma unroll
            for (int t = 0; t < 16; ++t) { if (i - t >= 0 && i - t <= 30) ya[t] += wk[i - t] * u; }
        }
#pragma unroll
        for (int t = 0; t < 16; ++t) *(LAS f32x2*)(ys + (16 * half + t) * 512 + c2) = ya[t];
        if (t0 == 2016) { const int c = tid; float* o = p.out + O_CSP + (size_t)seq * 30 * HW + c;
            for (int j = 0; j < 30; ++j) o[j * HW] = bf2f(us[(32 + j) * 512 + c]); }
    } else {
        const int c = tid;
        float wk[31];
        { const float* wp = p.dww + c;
#pragma unroll
          for (int k = 0; k < 31; ++k) { asm volatile("" : "+v"(wp)); wk[k] = *wp; wp += HW; } }
        const float bias = p.dwb[c];
        for (int tok = 0; tok < ntok; ++tok) {
            float y = bias;
#pragma unroll
            for (int k = 0; k < 31; ++k) y += wk[k] * bf2f(us[(tok + k) * 512 + c]);
            ys[tok * 512 + c] = y;
        }
        { float* o = p.out + O_CSS + (size_t)seq * 30 * HW + c; const float* sc = p.state_conv + (size_t)seq * 30 * HW + c;
            float tv[30];
#pragma unroll
            for (int j = 0; j < 30; ++j) { const int rr = j + 4; tv[j] = rr < 30 ? sc[rr * HW] : bf2f(us[rr * 512 + c]); }
#pragma unroll
            for (int j = 0; j < 30; ++j) o[j * HW] = tv[j]; }
    }
    __syncthreads();
#pragma unroll
    for (int ti_ = 0; ti_ < 4; ++ti_) {
        const int tok = w + 8 * ti_; if (tok >= ntok) break;
        const int c8 = lane * 8;
        const f32x4 a = *(const LAS f32x4*)(ys + tok * 512 + c8), b = *(const LAS f32x4*)(ys + tok * 512 + c8 + 4);
        const float mean = wave_sum((a[0] + a[1]) + (a[2] + a[3]) + (b[0] + b[1]) + (b[2] + b[3])) * (1.0f / 512.0f);
        const f32x4 da = a - mean, db = b - mean;
        const float var = wave_sum((da[0] * da[0] + da[1] * da[1]) + (da[2] * da[2] + da[3] * da[3]) + (db[0] * db[0] + db[1] * db[1]) + (db[2] * db[2] + db[3] * db[3])) * (1.0f / 512.0f);
        const float rstd = 1.0f / sqrtf(var + EPS);
        const f32x4 ga = *(const f32x4*)(p.lng + c8), gb = *(const f32x4*)(p.lng + c8 + 4), ba = *(const f32x4*)(p.lnb + c8), bb = *(const f32x4*)(p.lnb + c8 + 4);
        const f32x4 ya = da * rstd * ga + ba, yb = db * rstd * gb + bb;
        u32x4 o; o.x = cvt_pk_bf16(silu(ya[0]), silu(ya[1])); o.y = cvt_pk_bf16(silu(ya[2]), silu(ya[3])); o.z = cvt_pk_bf16(silu(yb[0]), silu(yb[1])); o.w = cvt_pk_bf16(silu(yb[2]), silu(yb[3]));
        *(u32x4*)(p.H + (size_t)(rowbase + t0 + tok) * D + 512 + c8) = o;
    }
    __syncthreads();
}


__device__ __forceinline__ void la_items(const P& p, LAS unsigned char* lds, int a0, int a1, int tid) {
    if (a0 >= a1) return;
    const int lane = tid & 63, w = __builtin_amdgcn_readfirstlane(tid >> 6), q = lane >> 4, i16 = lane & 15;
    LAS bf16_t* Ks = (LAS bf16_t*)lds; LAS bf16_t* Vs = Ks + 128 * VSTR;
    const int j = tid >> 2, part = tid & 3;
    Chunk kc, vc;
    { const int c = a0 & 15, bh = a0 >> 4, h = bh & 3, b = bh >> 2; const size_t r0 = (size_t)b * 2048 + c * 128;
      kc = chunk_load(p.K + r0 * HW + h * 128, tid); vc = chunk_load(p.V + r0 * HW + h * 128, tid); }
    for (int a = a0; a < a1; ++a) {
        const int c = a & 15, bh = a >> 4, h = bh & 3;
        { const float dec = __builtin_amdgcn_exp2f(lg2gamma(h) * (float)(127 - j));
#pragma unroll
          for (int i = 0; i < 4; ++i) { u32x4 v = kc.v[i];
              v.x = cvt_pk_bf16(bflo(v.x) * dec, bfhi(v.x) * dec); v.y = cvt_pk_bf16(bflo(v.y) * dec, bfhi(v.y) * dec); v.z = cvt_pk_bf16(bflo(v.z) * dec, bfhi(v.z) * dec); v.w = cvt_pk_bf16(bflo(v.w) * dec, bfhi(v.w) * dec);
              LAS u32x2* d = (LAS u32x2*)(Ks + j * VSTR + part * 32 + 8 * i); d[0] = (u32x2){v.x, v.y}; d[1] = (u32x2){v.z, v.w}; } }
        chunk_store<VSTR>(vc, Vs, tid);
        const bool more = a + 1 < a1; Chunk kn = kc, vn = vc;
        if (more) { const int cn = (a + 1) & 15, bhn = (a + 1) >> 4, hn = bhn & 3, bn = bhn >> 2; const size_t r0n = (size_t)bn * 2048 + cn * 128;
            kn = chunk_load(p.K + r0n * HW + hn * 128, tid); vn = chunk_load(p.V + r0n * HW + hn * 128, tid); }
        __syncthreads();
        f32x4 acc[8];
#pragma unroll
        for (int n = 0; n < 8; ++n) acc[n] = (f32x4){0.f, 0.f, 0.f, 0.f};
#pragma unroll
        for (int kk = 0; kk < 4; ++kk) {
            const bf16x8 kf = gather8(Ks, 32 * kk, 16 * w + i16, q);
#pragma unroll
            for (int n = 0; n < 8; ++n) { const bf16x8 vf = gather8(Vs, 32 * kk, 16 * n + i16, q); acc[n] = MFMA16(vf, kf, acc[n]); }
        }
        float* Lo = p.L + (size_t)(bh * 16 + c) * 16384 + (16 * w + i16) * 128 + 4 * q;
#pragma unroll
        for (int n = 0; n < 8; ++n) *(f32x4*)(Lo + 16 * n) = acc[n];
        __syncthreads();
        kc = kn; vc = vn;
    }
}
__device__ __forceinline__ void conv_rows_load(const P& p, int ci, u32x4 (&sv)[8], int w, int lane) {
    const int seq = ci >> 6, t0 = (ci & 63) * 32, rowbase = seq * 2048;
#pragma unroll
    for (int i = 0; i < 8; ++i) { const int rr = w + 8 * i, tau = t0 - 30 + rr;
        sv[i] = (u32x4){0u, 0u, 0u, 0u};
        if (rr < 62 && tau >= 0) sv[i] = *(const u32x4*)(p.U + (size_t)(rowbase + tau) * HW + lane * 8); }
}
__device__ __forceinline__ void conv_items(const P& p, LAS unsigned char* lds, int a0, int a1, int tid) {
    if (a0 >= a1) return;
    const int lane = tid & 63, w = __builtin_amdgcn_readfirstlane(tid >> 6);
    LAS bf16_t* us = (LAS bf16_t*)lds;
    LAS float* ys = (LAS float*)(lds + 63488);
    const int c2 = 2 * (tid & 255), half = tid >> 8;
    f32x2 wk[31];
    { const float* wp = p.dww + c2;
#pragma unroll
      for (int k = 0; k < 31; ++k) { asm volatile("" : "+v"(wp)); wk[k] = *(const f32x2*)wp; wp += HW; } }
    const f32x2 bias = *(const f32x2*)(p.dwb + c2);
    u32x4 sv[8]; conv_rows_load(p, a0, sv, w, lane);
    for (int ci = a0; ci < a1; ++ci) {
        const int seq = ci >> 6, t0 = (ci & 63) * 32, rowbase = seq * 2048;
#pragma unroll
        for (int i = 0; i < 8; ++i) { const int rr = w + 8 * i; if (rr < 62) *(LAS u32x4*)(us + rr * 512 + lane * 8) = sv[i]; }
        const bool more = ci + 1 < a1;
        if (more) conv_rows_load(p, ci + 1, sv, w, lane);
        __syncthreads();
        {
            f32x2 ya[16];
#pragma unroll
            for (int t = 0; t < 16; ++t) ya[t] = bias;
            const LAS bf16_t* ub = us + (16 * half) * 512 + c2;
#pragma unroll
            for (int i = 0; i < 46; ++i) {
                const unsigned uw = *(const LAS unsigned*)(ub + i * 512);
                const f32x2 u = (f32x2){bflo(uw), bfhi(uw)};
#pragma unroll
                for (int t = 0; t < 16; ++t) { if (i - t >= 0 && i - t <= 30) ya[t] += wk[i - t] * u; }
            }
#pragma unroll
            for (int t = 0; t < 16; ++t) *(LAS f32x2*)(ys + (16 * half + t) * 512 + c2) = ya[t];
            if (t0 == 2016) { const int c = tid; float* o = p.out + O_CSP + (size_t)seq * 30 * HW + c;
                for (int jj = 0; jj < 30; ++jj) o[jj * HW] = bf2f(us[(32 + jj) * 512 + c]); }
        }
        __syncthreads();
#pragma unroll
        for (int ti_ = 0; ti_ < 4; ++ti_) {
            const int tok = w + 8 * ti_; const int c8 = lane * 8;
            const f32x4 a = *(const LAS f32x4*)(ys + tok * 512 + c8), b = *(const LAS f32x4*)(ys + tok * 512 + c8 + 4);
            const float mean = wave_sum((a[0] + a[1]) + (a[2] + a[3]) + (b[0] + b[1]) + (b[2] + b[3])) * (1.0f / 512.0f);
            const f32x4 da = a - mean, db = b - mean;
            const float var = wave_sum((da[0] * da[0] + da[1] * da[1]) + (da[2] * da[2] + da[3] * da[3]) + (db[0] * db[0] + db[1] * db[1]) + (db[2] * db[2] + db[3] * db[3])) * (1.0f / 512.0f);
            const float rstd = 1.0f / sqrtf(var + EPS);
            const f32x4 ga = *(const f32x4*)(p.lng + c8), gb = *(const f32x4*)(p.lng + c8 + 4), ba = *(const f32x4*)(p.lnb + c8), bb = *(const f32x4*)(p.lnb + c8 + 4);
            const f32x4 yq = da * rstd * ga + ba, yb = db * rstd * gb + bb;
            u32x4 o; o.x = cvt_pk_bf16(silu(yq[0]), silu(yq[1])); o.y = cvt_pk_bf16(silu(yq[2]), silu(yq[3])); o.z = cvt_pk_bf16(silu(yb[0]), silu(yb[1])); o.w = cvt_pk_bf16(silu(yb[2]), silu(yb[3]));
            *(u32x4*)(p.H + (size_t)(rowbase + t0 + tok) * D + 512 + c8) = o;
        }
        __syncthreads();
    }
}

#define XB_TMO      128
#define XB_XCNT(j)  (256  + 64 * (j))
#define XB_XSUB(j)  (1280 + 64 * (j))
#define XB_XGEN(j)  (2304 + 64 * (j))
#define XB_TOP      3328
#define XB_TOPGEN   3392
#define XCD_BAR_WORDS 3456
#define XB_SPIN_CAP (1u << 18)

__device__ __forceinline__ unsigned xb_ld(unsigned* p)              { return __hip_atomic_load(p, __ATOMIC_RELAXED, __HIP_MEMORY_SCOPE_AGENT); }
__device__ __forceinline__ unsigned xb_add(unsigned* p, unsigned v) { return __hip_atomic_fetch_add(p, v, __ATOMIC_RELAXED, __HIP_MEMORY_SCOPE_AGENT); }
__device__ __forceinline__ unsigned xb_xcc_id() { return (unsigned)__builtin_amdgcn_s_getreg((3 << 11) | 20) & 0xFu; }
#define XB_SPIN(cond, bar) do { unsigned _sp = 0; while (cond) { __builtin_amdgcn_s_sleep(1); \
    if ((++_sp & 255u) == 0u) { if (xb_ld(&(bar)[XB_TMO])) break; if (_sp > XB_SPIN_CAP) { atomicAdd(&(bar)[XB_TMO], 1u); break; } } } } while (0)

struct XcdBarrier {
    unsigned* bar; unsigned x;
    volatile LAS unsigned* st;
};

__device__ __forceinline__ XcdBarrier xcd_barrier_post(unsigned* bar, volatile LAS unsigned* st) {
    XcdBarrier b; b.bar = bar; b.x = xb_xcc_id(); b.st = st;
    if (threadIdx.x == 0) (void)xb_add(&bar[XB_XCNT(b.x)], 1u);
    return b;
}
__device__ __forceinline__ void xcd_barrier_complete(unsigned* bar, unsigned x, unsigned& nloc, unsigned& nx) {
    const unsigned G = gridDim.x * gridDim.y * gridDim.z;
    unsigned sum, cnt, mine, sp = 0u;
    for (;;) {
        sum = 0u; cnt = 0u; mine = 0u;
#pragma unroll
        for (unsigned j = 0; j < 16; ++j) { const unsigned c = xb_ld(&bar[XB_XCNT(j)]); sum += c; cnt += (c > 0u) ? 1u : 0u; mine = (j == x) ? c : mine; }
        if (sum == G) break;
        __builtin_amdgcn_s_sleep(1);
        if ((++sp & 255u) == 0u) { if (xb_ld(&bar[XB_TMO])) break; if (sp > XB_SPIN_CAP) { atomicAdd(&bar[XB_TMO], 1u); break; } }
    }
    nloc = mine > 0u ? mine : 1u; nx = cnt > 0u ? cnt : 1u;
}

__device__ __forceinline__ void xcd_barrier(const XcdBarrier& b) {
    asm volatile("s_waitcnt vmcnt(0)" ::: "memory");
    __syncthreads();
    if (threadIdx.x == 0) {
        unsigned* bar = b.bar;
        __builtin_amdgcn_s_waitcnt(0);
        unsigned nloc = b.st[0], nx = b.st[1];
        if (nloc == 0u) { xcd_barrier_complete(bar, b.x, nloc, nx); b.st[0] = nloc; b.st[1] = nx; }
        const unsigned old = xb_add(&bar[XB_XSUB(b.x)], 1u);
        const unsigned gen = old / nloc;
        if (old + 1u == (gen + 1u) * nloc) {
            __builtin_amdgcn_fence(__ATOMIC_RELEASE, "agent");
            asm volatile("s_waitcnt vmcnt(0)" ::: "memory");
            const unsigned og = xb_add(&bar[XB_TOP], 1u);
            const unsigned tg = og / nx;
            if (og + 1u == (tg + 1u) * nx) xb_add(&bar[XB_TOPGEN], 1u);
            else XB_SPIN(xb_ld(&bar[XB_TOPGEN]) == tg, bar);
            __builtin_amdgcn_fence(__ATOMIC_ACQUIRE, "agent");
            asm volatile("s_waitcnt vmcnt(0)" ::: "memory");
        } else {
            XB_SPIN(xb_ld(&bar[XB_TOPGEN]) == gen, bar);
            __builtin_amdgcn_fence(__ATOMIC_ACQUIRE, "agent");
            asm volatile("s_waitcnt vmcnt(0)" ::: "memory");
        }
    }
    __syncthreads();
}

struct Args { const float* in[25]; float* out; unsigned char* ws; int ph_lo, ph_hi; int rep[4]; };
__global__ void __launch_bounds__(512, 2) fwd_kernel(Args args) {
    extern __shared__ __attribute__((aligned(16))) unsigned char lds_raw[];
    LAS unsigned char* lds = (LAS unsigned char*)lds_raw;
    cg::grid_group grid = cg::this_grid();
    const int tid = threadIdx.x, G = gridDim.x;
    if (tid < 64) ((LAS unsigned*)(lds + RING_BYTES))[tid] = 0u;
    __syncthreads();
    XcdBarrier bar = xcd_barrier_post((unsigned*)args.ws + 1024, (volatile LAS unsigned*)(lds + RING_BYTES) + 8);
    P p;
    p.xp = args.in[0]; p.xs = args.in[1]; p.cp = args.in[2]; p.cs = args.in[3]; p.state_ret = args.in[4]; p.state_conv = args.in[5];
    p.norm1 = args.in[6]; p.wg1 = args.in[7]; p.wu1 = args.in[8]; p.wd1 = args.in[9]; p.normmix = args.in[10]; p.win = args.in[11]; p.gngain = args.in[12];
    p.dww = args.in[13]; p.dwb = args.in[14]; p.lng = args.in[15]; p.lnb = args.in[16]; p.wout = args.in[17]; p.norm2 = args.in[18];
    p.wg2 = args.in[19]; p.wu2 = args.in[20]; p.wd2 = args.in[21]; p.wada = args.in[22]; p.bada = args.in[23]; p.normf = args.in[24];
    p.out = args.out; p.ws = args.ws;
    unsigned char* ws = args.ws;
    p.W1t = (bf16_t*)(ws + WS_W1); p.Wd1t = (bf16_t*)(ws + WS_WD1); p.Wint = (bf16_t*)(ws + WS_WIN); p.Woutt = (bf16_t*)(ws + WS_WOUT);
    p.W5t = (bf16_t*)(ws + WS_W5); p.Wd2t = (bf16_t*)(ws + WS_WD2); p.Wadat = (bf16_t*)(ws + WS_WADA); p.SC = (bf16_t*)(ws + WS_SC);
    p.H = (bf16_t*)(ws + WS_H); p.ACT = (bf16_t*)(ws + WS_ACT);
    p.Q = (bf16_t*)(ws + WS_ACT); p.K = (bf16_t*)(ws + WS_ACT + QKV_BYTES); p.V = (bf16_t*)(ws + WS_ACT + 2 * QKV_BYTES); p.G = (bf16_t*)(ws + WS_ACT + 3 * QKV_BYTES); p.U = (bf16_t*)(ws + WS_ACT + 4 * QKV_BYTES);
    p.ada = (float*)(ws + WS_ADA); p.ropeC = (float*)(ws + WS_ROPE); p.ropeS = p.ropeC + ROPE_N; p.L = (float*)(ws + WS_L); p.PART = (float*)(ws + WS_PART); p.XB = (bf16_t*)(ws + WS_XB); p.SP = (bf16_t*)(ws + WS_PART);
    float* X = p.out + O_Y;

    const int lo = args.ph_lo, hi = args.ph_hi;
#define IN(k) (lo <= (k) && (k) < hi)
#define SEAM(k) do { if (IN(k) && IN((k) + 1)) xcd_barrier(bar); } while (0)
    if (args.ph_lo < 0) grid.sync();

#define PH_0 do { prologue(p, lds, tid, G, 0, 0); } while (0)
#define PH_1 do { \
        pg8::Gemm g{p.SC, p.Wadat, 256, 9216, 1024}; pg8::StaticOrder S; S.init(256, 9216, 1024, G, (int)blockIdx.x); \
        pg8::EpiAda E{p.ada, p.bada}; \
        pg8::gemm_phase<pg8::EpiAda, pg8::StaticOrder, true, true>(lds, g, S, E); \
        prologue(p, lds, tid, G, 1, G > 72 ? 36 : 0); \
    } while (0)
#define PH_2 do { norm_mod_phase(p.xp, nullptr, p.xs, nullptr, nullptr, 0, p.norm1, p.ada, 0, 1, p.H, tid, G); } while (0)
#define PH_3 do { \
        pg8::Gemm g{p.H, p.W1t, M, 2 * FF, 1024}; pg8::StaticOrder S; S.init(M, 2 * FF, 1024, G, (int)blockIdx.x); \
        pg8::EpiSwiGLU E{p.ACT}; \
        pg8::gemm_phase<pg8::EpiSwiGLU, pg8::StaticOrder, true, true>(lds, g, S, E); \
    } while (0)
#define PH_4 do { \
        pg8::Gemm g{p.ACT, p.Wd1t, M, 1024, FF}; pg8::ResidOrder S; S.init(MP, 1024, FF, G, (int)blockIdx.x, 11); \
        pg8::EpiResid<true> E{p.xp, nullptr, p.XB, p.PART, p.ada + 2 * 1024, 0.5f}; \
        pg8::gemm_phase<pg8::EpiResid<true>, pg8::ResidOrder, true, true>(lds, g, S, E); \
    } while (0)
#define PH_5 do { norm_mod_phase(nullptr, p.XB, p.xs, X + (size_t)MP * D, p.PART, 11, p.normmix, p.ada, 3, 4, p.H, tid, G); } while (0)
#define PH_6 do { \
        pg8::Gemm g{p.H, p.Wint, M, NIN, 1024}; pg8::StaticOrder S; S.init(MP, NIN, 1024, G, (int)blockIdx.x); \
        pg8::EpiMix E{p.Q, p.K, p.V, p.G, p.U, p.ropeC, p.ropeS}; \
        pg8::gemm_phase<pg8::EpiMix, pg8::StaticOrder, true, true>(lds, g, S, E); \
    } while (0)
#define PH_7 do { \
        const int nb0 = G > 48 ? 24 : 0; \
        if ((int)blockIdx.x < 24) { \
            pg8::Gemm g{p.H, p.Wint, M, NIN, 1024}; pg8::SampleOrder S; S.init(MP, NIN, 1024, (int)blockIdx.x); \
            pg8::EpiMix E{p.Q, p.K, p.V, p.G, p.U, p.ropeC, p.ropeS}; \
            pg8::gemm_phase<pg8::EpiMix, pg8::SampleOrder, true, true>(lds, g, S, E); \
        } \
        if ((int)blockIdx.x >= nb0) { \
            const int nbk = G - nb0, bi = (int)blockIdx.x - nb0, per = 1024 / nbk, ext = 1024 % nbk; \
            const int i0 = bi * per + (bi < ext ? bi : ext), i1 = i0 + per + (bi < ext ? 1 : 0);     \
            la_items(p, lds, (i0 + 1) >> 1, (i1 + 1) >> 1, tid);            \
            conv_items(p, lds, i0 >> 1, i1 >> 1, tid);                       \
        } \
    } while (0)
#define PH_8 do { \
        scan_phase(p, tid, G); xcd_barrier(bar); \
        for (int rep_ = 0; rep_ < args.rep[0]; ++rep_) for (int it = blockIdx.x; it < 512; it += G) { \
            const int id2 = it & 255, bh = id2 >> 3, c = it < 256 ? (id2 & 7) : 15 - (id2 & 7); \
            retb_item(p, lds, bh >> 2, bh & 3, c, tid); \
        } \
        for (int rep_ = 0; rep_ < args.rep[1]; ++rep_) for (int it = blockIdx.x; it < 512; it += G) sret_item(p, lds, it >> 2, it & 3, tid); \
        for (int rep_ = 0; rep_ < args.rep[2]; ++rep_) for (int it = blockIdx.x; it < 128; it += G) conv_item<true>(p, lds, it, 0, 4, tid); \
    } while (0)
#define PH_9 do { \
        pg8::Gemm g{p.H, p.Woutt, M, 1024, 1024}; pg8::ResidOrder S; S.init(MP, 1024, 1024, G, (int)blockIdx.x, 8); \
        pg8::EpiResid<false> E{nullptr, p.XB, p.XB, p.PART, p.ada + 5 * 1024, 1.0f}; \
        pg8::gemm_phase<pg8::EpiResid<false>, pg8::ResidOrder, true, true>(lds, g, S, E); \
    } while (0)
#define PH_10 do { norm_mod_phase(nullptr, p.XB, X + (size_t)MP * D, X + (size_t)MP * D, p.PART, 8, p.norm2, p.ada, 6, 7, p.H, tid, G); } while (0)
#define PH_11 do { \
        pg8::Gemm g{p.H, p.W5t, M, 2 * FF, 1024}; pg8::StaticOrder S; S.init(M, 2 * FF, 1024, G, (int)blockIdx.x); \
        pg8::EpiSwiGLU E{p.ACT}; \
        pg8::gemm_phase<pg8::EpiSwiGLU, pg8::StaticOrder, true, true>(lds, g, S, E); \
    } while (0)
#define PH_12 do { \
        pg8::Gemm g{p.ACT, p.Wd2t, M, 1024, FF}; pg8::ResidOrder S; S.init(MP, 1024, FF, G, (int)blockIdx.x, 11); \
        pg8::EpiResid<false> E{nullptr, p.XB, p.XB, p.PART, p.ada + 8 * 1024, 0.5f}; \
        pg8::gemm_phase<pg8::EpiResid<false>, pg8::ResidOrder, true, true>(lds, g, S, E); \
    } while (0)
#define PH_13 do { final_norm_phase(X, p.XB, p.PART, 11, p.normf, tid, G); } while (0)

#ifdef SYNCPROBE
    for (int i_ = 0; i_ < SYNCPROBE; ++i_) xcd_barrier(bar);
#endif
    if (IN(0)) { PH_0; if ((REPMASK >> 0) & 1) { xcd_barrier(bar); PH_0; } } SEAM(0);
    if (IN(1)) { PH_1; if ((REPMASK >> 1) & 1) { xcd_barrier(bar); PH_1; } } SEAM(1);
    if (IN(2)) { PH_2; if ((REPMASK >> 2) & 1) { xcd_barrier(bar); PH_2; } } SEAM(2);
    if (IN(3)) { PH_3; if ((REPMASK >> 3) & 1) { xcd_barrier(bar); PH_3; } } SEAM(3);
    if (IN(4)) { PH_4; if ((REPMASK >> 4) & 1) { xcd_barrier(bar); PH_4; } } SEAM(4);
    if (IN(5)) { PH_5; if ((REPMASK >> 5) & 1) { xcd_barrier(bar); PH_5; } } SEAM(5);
    if (IN(6)) { PH_6; if ((REPMASK >> 6) & 1) { xcd_barrier(bar); PH_6; } } SEAM(6);
    if (IN(7)) { PH_7; if ((REPMASK >> 7) & 1) { xcd_barrier(bar); PH_7; } } SEAM(7);
    if (IN(8)) { PH_8; if ((REPMASK >> 8) & 1) { xcd_barrier(bar); PH_8; } } SEAM(8);
    if (IN(9)) { PH_9; if ((REPMASK >> 9) & 1) { xcd_barrier(bar); PH_9; } } SEAM(9);
    if (IN(10)) { PH_10; if ((REPMASK >> 10) & 1) { xcd_barrier(bar); PH_10; } } SEAM(10);
    if (IN(11)) { PH_11; if ((REPMASK >> 11) & 1) { xcd_barrier(bar); PH_11; } } SEAM(11);
    if (IN(12)) { PH_12; if ((REPMASK >> 12) & 1) { xcd_barrier(bar); PH_12; } } SEAM(12);
    if (IN(13)) { PH_13; if ((REPMASK >> 13) & 1) { xcd_barrier(bar); PH_13; } }
#undef IN
#undef SEAM
}

extern "C" void kernel_launch(void* const* d_in, const int* in_sizes, int n_in, void* d_out, int out_size, void* d_ws, size_t ws_size, hipStream_t stream) {
    static int grid = 0;
    if (grid == 0) {
        if (n_in != 25 || ws_size < WS_END) { fprintf(stderr, "kernel_launch: unexpected n_in %d / ws_size %zu\n", n_in, ws_size); grid = -1; return; }
        int dev = 0, cus = 0, per_cu = 0;
        if (hipGetDevice(&dev) != hipSuccess || hipDeviceGetAttribute(&cus, hipDeviceAttributeMultiprocessorCount, dev) != hipSuccess) { grid = -1; return; }
        if (hipFuncSetAttribute((const void*)fwd_kernel, hipFuncAttributeMaxDynamicSharedMemorySize, LDS_BYTES) != hipSuccess) { fprintf(stderr, "kernel_launch: hipFuncSetAttribute failed\n"); grid = -1; return; }
        if (hipOccupancyMaxActiveBlocksPerMultiprocessor(&per_cu, (const void*)fwd_kernel, 512, LDS_BYTES) != hipSuccess || per_cu < 1) { fprintf(stderr, "kernel_launch: occupancy query says %d\n", per_cu); per_cu = 1; }
        (void)hipGetLastError();
        grid = cus;
    }
    if (grid < 0) return;
    if (hipMemsetAsync(d_ws, 0, 20480, stream) != hipSuccess) { fprintf(stderr, "kernel_launch: memset failed\n"); return; }
    Args a{};
    for (int i = 0; i < 25; ++i) a.in[i] = (const float*)d_in[i];
    a.out = (float*)d_out; a.ws = (unsigned char*)d_ws;
    a.rep[0] = PROBE_R0; a.rep[1] = PROBE_R1; a.rep[2] = PROBE_R2; a.rep[3] = 1;
#if MK_N_LAUNCHES == 1
    a.ph_lo = 0; a.ph_hi = NPHASE;
    void* kargs[] = {&a};
    hipError_t e = hipLaunchCooperativeKernel((const void*)fwd_kernel, dim3(grid), dim3(512), kargs, LDS_BYTES, stream);
    if (e != hipSuccess) fprintf(stderr, "kernel_launch: cooperative launch failed: %s (grid %d)\n", hipGetErrorString(e), grid);
#else
    for (int ph = 0; ph < NPHASE; ++ph) { a.ph_lo = ph; a.ph_hi = ph + 1; hipLaunchKernelGGL(fwd_kernel, dim3(grid), dim3(512), LDS_BYTES, stream, a); }
#endif
}
```
